# Optimizing an MI355X kernel written in HIP

```python
import math
import jax
import jax.numpy as jnp
from jax import lax
import numpy as np

D_MODEL = 1024
BATCH = 4
SEQ = 4096
DEPTH = 1

N_META = 16
D_MIX = 2 * D_MODEL
EPS = 1e-6
HG_WIDTH = D_MIX // 2
HG_DK = 128
HG_HEADS = HG_WIDTH // 128
HG_DV = HG_WIDTH // HG_HEADS
HG_KEY = HG_HEADS * HG_DK
HG_CHUNK = 16
M2_WIDTH = D_MIX - HG_WIDTH
M2_HEADDIM = 64
M2_HEADS = M2_WIDTH // M2_HEADDIM
M2_STATE = 128
M2_GROUPS = 2
M2_HPG = M2_HEADS // M2_GROUPS
M2_GN = M2_GROUPS * M2_STATE
M2_XBC = M2_WIDTH + 2 * M2_GN
M2_CONV = 4
M2_CHUNK = 64
DT_MIN = 1e-3
DT_MAX = 1e-1
D_FF = 2816
FFN_CONV = 3
PROJ_SIZES = (HG_KEY, HG_KEY, HG_WIDTH, HG_WIDTH, M2_WIDTH, M2_XBC, M2_HEADS)
D_PROJ = sum(PROJ_SIZES)
PROJ_SPLITS = tuple(int(v) for v in np.cumsum(PROJ_SIZES)[:-1])

kernel_name = 'hybrid_hgrn2_mamba2_convffn'


def rmsnorm(x, w):
    xf = x.astype(jnp.float32)
    y = xf * lax.rsqrt(jnp.mean(xf * xf, axis=-1, keepdims=True) + EPS)
    return (y * w.astype(jnp.float32)).astype(x.dtype)


def causal_dwconv(x, w, b):
    k_taps, length = w.shape[0], x.shape[1]
    xp = jnp.pad(x, ((0, 0), (k_taps - 1, 0), (0, 0)))
    y = b + xp[:, 0:length] * w[0]
    for k in range(1, k_taps):
        y = y + xp[:, k:k + length] * w[k]
    return y


def front_pad(t, n):
    return jnp.pad(t, ((0, 0), (n, 0)) + ((0, 0),) * (t.ndim - 2))


def to_chunks(t, c):
    return t.reshape((t.shape[0], t.shape[1] // c, c) + t.shape[2:])


def hgrn2_mixer(q, f_pre, i_in, g, lb, norm_w):
    bsz, length, _ = q.shape
    f32 = jnp.float32
    f = lb + (1.0 - lb) * jax.nn.sigmoid(f_pre.astype(f32))
    k = 1.0 - f
    log_f = jnp.log(f)
    qa = jax.nn.silu(q.astype(f32))
    pad = (-N_META) % HG_CHUNK
    lp = length + pad

    def prep(t, d):
        return to_chunks(front_pad(t, pad).reshape(bsz, lp, HG_HEADS, d), HG_CHUNK)

    qc, kc, gc = prep(qa, HG_DK), prep(k, HG_DK), prep(log_f, HG_DK)
    vc = prep(i_in.astype(f32), HG_DV)
    bcum = jnp.cumsum(gc, axis=2)
    blast = bcum[:, :, -1]
    q_dec = qc * jnp.exp(bcum)
    k_inv = kc * jnp.exp(-bcum)
    k_end = kc * jnp.exp(blast[:, :, None] - bcum)
    causal = jnp.tril(jnp.ones((HG_CHUNK, HG_CHUNK), dtype=bool))
    scores = jnp.einsum('bnrhk,bnshk->bnhrs', q_dec, k_inv)
    scores = jnp.where(causal, scores, 0.0)
    o_intra = jnp.einsum('bnhrs,bnshv->bnrhv', scores, vc)

    def step(state, inp):
        q_n, k_n, v_n, d_n = inp
        o_n = jnp.einsum('brhk,bhkv->brhv', q_n, state)
        state = d_n[..., None] * state + jnp.einsum('brhk,brhv->bhkv', k_n, v_n)
        return state, o_n

    s0 = jnp.zeros((bsz, HG_HEADS, HG_DK, HG_DV), f32)
    xs = (jnp.moveaxis(q_dec, 1, 0), jnp.moveaxis(k_end, 1, 0),
          jnp.moveaxis(vc, 1, 0), jnp.moveaxis(jnp.exp(blast), 1, 0))
    _, o_inter = lax.scan(step, s0, xs)
    o = o_intra + jnp.moveaxis(o_inter, 0, 1)
    o = o.reshape(bsz, lp, HG_HEADS, HG_DV)[:, pad:]
    o = o * lax.rsqrt(jnp.mean(o * o, axis=-1, keepdims=True) + EPS)
    o = o.reshape(bsz, length, HG_WIDTH) * norm_w.astype(f32)
    return (o * jax.nn.silu(g.astype(f32))).astype(q.dtype)


def mamba2_mixer(z, xbc, dt_pre, conv_w, conv_b, dt_bias, a_log, d_skip, norm_w):
    bsz, length, _ = z.shape
    f32 = jnp.float32
    xbc = jax.nn.silu(causal_dwconv(xbc, conv_w, conv_b).astype(f32))
    x_in = xbc[..., :M2_WIDTH].reshape(bsz, length, M2_GROUPS, M2_HPG, M2_HEADDIM)
    b_in = xbc[..., M2_WIDTH:M2_WIDTH + M2_GN].reshape(bsz, length, M2_GROUPS, M2_STATE)
    c_in = xbc[..., M2_WIDTH + M2_GN:].reshape(bsz, length, M2_GROUPS, M2_STATE)
    dt = jax.nn.softplus(dt_pre.astype(f32) + dt_bias.astype(f32))
    dt = dt.reshape(bsz, length, M2_GROUPS, M2_HPG)
    a = -jnp.exp(a_log.astype(f32)).reshape(M2_GROUPS, M2_HPG)
    da = dt * a
    xdt = x_in * dt[..., None]
    pad = (-N_META) % M2_CHUNK
    lp = length + pad
    xc = to_chunks(front_pad(xdt, pad), M2_CHUNK)
    ac = to_chunks(front_pad(da, pad), M2_CHUNK)
    bc = to_chunks(front_pad(b_in, pad), M2_CHUNK)
    cc = to_chunks(front_pad(c_in, pad), M2_CHUNK)
    a_cum = jnp.cumsum(ac, axis=2)
    causal = jnp.tril(jnp.ones((M2_CHUNK, M2_CHUNK), dtype=bool))
    seg = a_cum[:, :, :, None] - a_cum[:, :, None, :]
    l_mat = jnp.exp(jnp.where(causal[:, :, None, None], seg, -jnp.inf))
    cb = jnp.einsum('bnigs,bnjgs->bnijg', cc, bc)
    y_diag = jnp.einsum('bnijgh,bnjghp->bnighp', cb[..., None] * l_mat, xc)
    decay_to_end = jnp.exp(a_cum[:, :, -1:] - a_cum)
    u = jnp.einsum('bnjgs,bnjghp->bnghps', bc, xc * decay_to_end[..., None])
    chunk_decay = jnp.exp(a_cum[:, :, -1])

    def step(state, inp):
        c_n, e_n, u_n, d_n = inp
        y_n = jnp.einsum('bigs,bghps->bighp', c_n, state) * e_n[..., None]
        state = d_n[..., None, None] * state + u_n
        return state, y_n

    s0 = jnp.zeros((bsz, M2_GROUPS, M2_HPG, M2_HEADDIM, M2_STATE), f32)
    xs = (jnp.moveaxis(cc, 1, 0), jnp.moveaxis(jnp.exp(a_cum), 1, 0),
          jnp.moveaxis(u, 1, 0), jnp.moveaxis(chunk_decay, 1, 0))
    _, y_off = lax.scan(step, s0, xs)
    y = y_diag + jnp.moveaxis(y_off, 0, 1)
    y = y.reshape(bsz, lp, M2_GROUPS, M2_HPG, M2_HEADDIM)[:, pad:]
    y = y + d_skip.astype(f32).reshape(M2_GROUPS, M2_HPG, 1) * x_in
    y = y.reshape(bsz, length, M2_WIDTH) * jax.nn.silu(z.astype(f32))
    yg = y.reshape(bsz, length, M2_GROUPS, M2_WIDTH // M2_GROUPS)
    yg = yg * lax.rsqrt(jnp.mean(yg * yg, axis=-1, keepdims=True) + EPS)
    y = yg.reshape(bsz, length, M2_WIDTH) * norm_w.astype(f32)
    return y.astype(z.dtype)


def conv_glu_ffn(h, w_up, conv_w, conv_b, w_down):
    u = causal_dwconv(h @ w_up, conv_w, conv_b)
    gate, val = jnp.split(u, 2, axis=-1)
    return (jax.nn.silu(gate) * val) @ w_down


def setup_inputs(seed: int = 0) -> dict:
    key = jax.random.key(seed)
    ks = jax.random.split(key, 20)
    f32 = jnp.float32

    def nrm(k, shape, scale):
        return scale * jax.random.normal(k, shape, f32)

    def gain(k, shape):
        return 1.0 + 0.05 * jax.random.normal(k, shape, f32)

    dt0 = jnp.exp(jax.random.uniform(ks[8], (DEPTH, M2_HEADS), f32,
                                     minval=math.log(DT_MIN), maxval=math.log(DT_MAX)))
    dt_bias = dt0 + jnp.log(-jnp.expm1(-dt0))
    a_log = jnp.log(jax.random.uniform(ks[9], (DEPTH, M2_HEADS), f32, minval=1.0, maxval=16.0))
    return {
        'x': nrm(ks[0], (BATCH, SEQ, D_MODEL), 1.0),
        'meta_tokens': nrm(ks[1], (N_META, D_MODEL), 1.0),
        'norm1_w': gain(ks[2], (DEPTH, D_MODEL)),
        'w_in': nrm(ks[3], (DEPTH, D_MODEL, D_PROJ), D_MODEL ** -0.5),
        'hg_lb_logits': nrm(ks[4], (DEPTH + 1, HG_KEY), 0.1),
        'hg_norm_w': gain(ks[5], (DEPTH, HG_WIDTH)),
        'm2_conv_w': nrm(ks[6], (DEPTH, M2_CONV, M2_XBC), M2_CONV ** -0.5),
        'm2_conv_b': nrm(ks[7], (DEPTH, M2_XBC), 0.02),
        'm2_dt_bias': dt_bias,
        'm2_a_log': a_log,
        'm2_d': gain(ks[10], (DEPTH, M2_HEADS)),
        'm2_norm_w': gain(ks[11], (DEPTH, M2_WIDTH)),
        'w_out': nrm(ks[12], (DEPTH, D_MIX, D_MODEL), D_MIX ** -0.5),
        'norm2_w': gain(ks[13], (DEPTH, D_MODEL)),
        'ffn_w_up': nrm(ks[14], (DEPTH, D_MODEL, 2 * D_FF), D_MODEL ** -0.5),
        'ffn_conv_w': nrm(ks[15], (DEPTH, FFN_CONV, 2 * D_FF), FFN_CONV ** -0.5),
        'ffn_conv_b': nrm(ks[16], (DEPTH, 2 * D_FF), 0.02),
        'ffn_w_down': nrm(ks[17], (DEPTH, D_FF, D_MODEL), D_FF ** -0.5),
        'final_norm_w': gain(ks[18], (D_MODEL,)),
    }


def reference(x, meta_tokens, norm1_w, w_in, hg_lb_logits, hg_norm_w, m2_conv_w, m2_conv_b,
              m2_dt_bias, m2_a_log, m2_d, m2_norm_w, w_out, norm2_w, ffn_w_up, ffn_conv_w,
              ffn_conv_b, ffn_w_down, final_norm_w):
    bsz = x.shape[0]
    meta = jnp.broadcast_to(meta_tokens.astype(x.dtype)[None], (bsz, N_META, D_MODEL))
    h = jnp.concatenate([meta, x], axis=1)
    lbs = jnp.cumsum(jax.nn.softmax(hg_lb_logits.astype(jnp.float32), axis=0), axis=0)
    for l in range(DEPTH):
        u = rmsnorm(h, norm1_w[l])
        proj = u @ w_in[l]
        hg_q, hg_f, hg_i, hg_g, m2_z, m2_xbc, m2_dt = jnp.split(proj, PROJ_SPLITS, axis=-1)
        out_a = hgrn2_mixer(hg_q, hg_f, hg_i, hg_g, lbs[l], hg_norm_w[l])
        out_b = mamba2_mixer(m2_z, m2_xbc, m2_dt, m2_conv_w[l], m2_conv_b[l], m2_dt_bias[l],
                             m2_a_log[l], m2_d[l], m2_norm_w[l])
        h = h + jnp.concatenate([out_a, out_b], axis=-1) @ w_out[l]
        h = h + conv_glu_ffn(rmsnorm(h, norm2_w[l]), ffn_w_up[l], ffn_conv_w[l],
                             ffn_conv_b[l], ffn_w_down[l])
    y = rmsnorm(h, final_norm_w)
    return y[:, N_META:, :]
```

```cpp
#include <hip/hip_runtime.h>
#include <cstdio>
#include <cstdint>

#ifndef MK_PER_PHASE
#define MK_PER_PHASE 0
#endif
#ifndef MK_SLOW_MIXERS
#define MK_SLOW_MIXERS 1
#endif

namespace pg8 {
#define PG8_LAS __attribute__((address_space(3)))
typedef unsigned short bf16_t;
typedef short bf16x8 __attribute__((ext_vector_type(8)));
typedef float f32x4 __attribute__((ext_vector_type(4)));
typedef unsigned u32x4 __attribute__((ext_vector_type(4)));
constexpr int BM = 256, BK = 64, HALF = 128, HTB = HALF * BK * 2  , STAGE_BYTES = 8 * HTB, NXCD = 8, WGM = 8;

__host__ __device__ __forceinline__ int lds_byte(int r, int c) { const int st = (r >> 4) * 2 + (c >> 5), rr = r & 15, cc = c & 31, ob = rr * 64 + cc * 2; return st * 1024 + (ob ^ (((ob >> 9) & 1) << 5)); }
__host__ __device__ __forceinline__ void stage_rc(int b, int& R, int& C) { const int st = b / 1024, sb = b % 1024, swz = sb ^ (((sb >> 9) & 1) << 5); R = (st >> 1) * 16 + swz / 64; C = (st & 1) * 32 + (swz % 64) / 2; }
__host__ __device__ __forceinline__ int perm32(int rho) { const int n = rho >> 4, i = rho & 15; return 8 * (i >> 2) + 4 * n + (i & 3); }

struct Unit { int pm, pn; };
struct Gemm { const bf16_t* A; const bf16_t* Bt; int M, N, K; int lda; int ksplit; int kjump; };

struct StaticOrder {
    int nM, nN, nwg, G, c;
    __host__ __device__ void init(int M, int N, int G_, int c_) { nM = M / BM; nN = N / BM; nwg = nM * nN; G = G_; c = c_; }
    __host__ __device__ bool next(int i, Unit& u) const {
        const long L = (long)i * G + c; if (L >= nwg) return false;
        int wgid = (int)L; { const int q = nwg / NXCD, r = nwg % NXCD, xcd = wgid % NXCD, off = wgid / NXCD; wgid = (xcd < r ? xcd * (q + 1) : r * (q + 1) + (xcd - r) * q) + off; }
        const int nig = WGM * nN, gid = wgid / nig, fm = gid * WGM, gsz = (nM - fm) < WGM ? (nM - fm) : WGM;
        u.pm = fm + ((wgid % nig) % gsz); u.pn = (wgid % nig) / gsz; return true;
    }
    __device__ __forceinline__ void a_ready(const Unit&) const {}
    __device__ __forceinline__ void done(const Unit&) const {}
};

__device__ __forceinline__ unsigned cvt_pk_bf16(float lo, float hi) { unsigned r; asm volatile("v_cvt_pk_bf16_f32 %0, %1, %2" : "=v"(r) : "v"(lo), "v"(hi)); return r; }
__device__ __forceinline__ u32x4 pack8(const f32x4 v0, const f32x4 v1) { u32x4 w; w.x = cvt_pk_bf16(v0[0], v0[1]); w.y = cvt_pk_bf16(v0[2], v0[3]); w.z = cvt_pk_bf16(v1[0], v1[1]); w.w = cvt_pk_bf16(v1[2], v1[3]); return w; }

struct EpiBf16 {
    static constexpr bool PERM = true, AFTER_DRAIN = false;
    bf16_t* O; int ldc;
    __device__ __forceinline__ void operator()(const f32x4 (&acc)[2][2][4][2], const Unit& u, int wr, int wc, int fr, int fq) const {
        const int row0 = u.pm * BM + wr * 64 + fr, col0 = u.pn * BM + wc * 32 + 8 * fq;
#pragma unroll
        for (int ai = 0; ai < 2; ++ai)
#pragma unroll
            for (int m = 0; m < 4; ++m) { bf16_t* rowp = O + (size_t)(row0 + ai * HALF + m * 16) * ldc + col0;
#pragma unroll
                for (int bj = 0; bj < 2; ++bj) *(u32x4*)(rowp + bj * HALF) = pack8(acc[ai][bj][m][0], acc[ai][bj][m][1]); }
    }
};
template <bool WRITE_A2> struct EpiResid {
    static constexpr bool PERM = true, AFTER_DRAIN = false;
    const float* base; float* out; bf16_t* a2; int lda2; float* rss;
    __device__ __forceinline__ void operator()(const f32x4 (&acc)[2][2][4][2], const Unit& u, int wr, int wc, int fr, int fq) const {
        const int row0 = u.pm * BM + wr * 64 + fr, col0 = u.pn * BM + wc * 32 + 8 * fq;
#pragma unroll
        for (int ai = 0; ai < 2; ++ai)
#pragma unroll
            for (int m = 0; m < 4; ++m) { const int row = row0 + ai * HALF + m * 16; float ss = 0.f;
#pragma unroll
                for (int bj = 0; bj < 2; ++bj) { const size_t o = (size_t)row * 1024 + col0 + bj * HALF;
                    const f32x4 v0 = acc[ai][bj][m][0] + *(const f32x4*)(base + o), v1 = acc[ai][bj][m][1] + *(const f32x4*)(base + o + 4);
                    *(f32x4*)(out + o) = v0; *(f32x4*)(out + o + 4) = v1;
                    ss += (v0[0] * v0[0] + v0[1] * v0[1]) + (v0[2] * v0[2] + v0[3] * v0[3]) + (v1[0] * v1[0] + v1[1] * v1[1]) + (v1[2] * v1[2] + v1[3] * v1[3]);
                    if (WRITE_A2) *(u32x4*)(a2 + (size_t)row * lda2 + col0 + bj * HALF) = pack8(v0, v1); }
                ss += __shfl_xor(ss, 16); ss += __shfl_xor(ss, 32);
                if (fq == 0) rss[(size_t)row * 16 + u.pn * 4 + wc] = ss; }
    }
};
struct EpiUp {
    static constexpr bool PERM = true, AFTER_DRAIN = false;
    bf16_t* proj; const float* rss; bf16_t* halo;
    __device__ __forceinline__ void operator()(const f32x4 (&acc)[2][2][4][2], const Unit& u, int wr, int wc, int fr, int fq) const {
        const int row0 = u.pm * BM + wr * 64 + fr, jc = u.pn * 128 + wc * 32 + 8 * fq;
        const int dcol[2] = { 2048 + jc, (u.pn < 8) ? jc : jc + 3840 };
#pragma unroll
        for (int ai = 0; ai < 2; ++ai)
#pragma unroll
            for (int m = 0; m < 4; ++m) { const int row = row0 + ai * HALF + m * 16;
                const f32x4* rp = (const f32x4*)(rss + (size_t)row * 16); const f32x4 a = rp[0], b = rp[1], c = rp[2], d = rp[3];
                const float tot = (((a[0] + a[1]) + (a[2] + a[3])) + ((b[0] + b[1]) + (b[2] + b[3]))) + (((c[0] + c[1]) + (c[2] + c[3])) + ((d[0] + d[1]) + (d[2] + d[3])));
                const float rs = 1.0f / sqrtf(tot * (1.0f / 1024.0f) + 1e-6f);
#pragma unroll
                for (int bj = 0; bj < 2; ++bj) { const u32x4 w = pack8(acc[ai][bj][m][0] * rs, acc[ai][bj][m][1] * rs);
                    *(u32x4*)(proj + (size_t)row * 6912 + dcol[bj]) = w;
                    if ((row & 63) >= 62) *(u32x4*)(halo + (size_t)((row >> 6) * 2 + (row & 1)) * 5632 + bj * 2816 + jc) = w; } }
    }
};

template <class Epi, class Sched, bool ALIGN_EPI = false, bool SP2 = false>
__device__ __forceinline__ void gemm_phase(PG8_LAS unsigned char* lds, const Gemm g, const Sched& S, const Epi& E) {
    const int tid = threadIdx.x, wid = __builtin_amdgcn_readfirstlane(tid >> 6), lane = tid & 63, wr = wid >> 2, wc = wid & 3, fr = lane & 15, fq = lane >> 4;
    const int K = g.K, nt = K / BK, lda = g.lda;
    unsigned voffA[2], voffB[2];
#pragma unroll
    for (int i = 0; i < 2; ++i) { int R, C; stage_rc(tid * 16 + i * 8192, R, C); const int Rb = Epi::PERM ? ((R & ~31) + perm32(R & 31)) : R;
        voffA[i] = (unsigned)(R * lda + C) * 2u; voffB[i] = (unsigned)(Rb * K + C) * 2u; }
    const size_t kstep = (size_t)(BK * 2);
    const size_t hstepA = (size_t)HALF * lda * 2, tstepA = 2 * hstepA;
    const size_t hstepB = (size_t)HALF * K * 2, tstepB = 2 * hstepB;
    const int ksplit = g.ksplit; const size_t kjump = (size_t)g.kjump;
#define PG8_AK(kt) ((size_t)(kt) * kstep + (((kt) >= ksplit) ? kjump : (size_t)0))
    const unsigned ldsw = (unsigned)wid * 1024u;
    const int aoff = lds_byte(wr * 64 + fr, fq * 8), boff = lds_byte(wc * 32 + fr, fq * 8);
#define PG8_SA(b, h) (((b) * 2 + (h)) * HTB)
#define PG8_SB(b, h) ((4 + (b) * 2 + (h)) * HTB)
#define PG8_STAGE(bufoff, gbase, voff) do { _Pragma("unroll") for (int _i = 0; _i < 2; ++_i) \
        __builtin_amdgcn_global_load_lds((const unsigned*)((const char*)(gbase) + (voff)[_i]), (PG8_LAS unsigned*)(lds + (bufoff) + ldsw + _i * 8192), 16, 0, 0); } while (0)
#define PG8_LDA(dst, b, h) do { _Pragma("unroll") for (int m = 0; m < 4; ++m) _Pragma("unroll") for (int k = 0; k < 2; ++k) dst[m][k] = *(const PG8_LAS bf16x8*)(lds + PG8_SA(b, h) + aoff + m * 2048 + k * 1024); } while (0)
#define PG8_LDB(dst, b, h) do { _Pragma("unroll") for (int n = 0; n < 2; ++n) _Pragma("unroll") for (int k = 0; k < 2; ++k) dst[n][k] = *(const PG8_LAS bf16x8*)(lds + PG8_SB(b, h) + boff + n * 2048 + k * 1024); } while (0)
#define PG8_MMA(ai, bj, At, Bt) do { __builtin_amdgcn_s_setprio(1); _Pragma("unroll") for (int m = 0; m < 4; ++m) _Pragma("unroll") for (int n = 0; n < 2; ++n) _Pragma("unroll") for (int k = 0; k < 2; ++k) \
        acc[ai][bj][m][n] = __builtin_amdgcn_mfma_f32_16x16x32_bf16(Bt[n][k], At[m][k], acc[ai][bj][m][n], 0, 0, 0); __builtin_amdgcn_s_setprio(0); } while (0)
#define PG8_WAIT_V(n) asm volatile("s_waitcnt vmcnt(" #n ")" ::: "memory")
#define PG8_WAIT_L(n) asm volatile("s_waitcnt lgkmcnt(" #n ")" ::: "memory")
#define PG8_BAR __builtin_amdgcn_s_barrier()
#define PG8_SCHED __builtin_amdgcn_sched_barrier(0)
    Unit cur, nxt; int ui = 0;
    if (!S.next(0, cur)) return;
    f32x4 acc[2][2][4][2];
#pragma unroll
    for (int a = 0; a < 2; ++a)
#pragma unroll
        for (int b = 0; b < 2; ++b)
#pragma unroll
            for (int m = 0; m < 4; ++m)
#pragma unroll
                for (int n = 0; n < 2; ++n) acc[a][b][m][n] = (f32x4){0.f, 0.f, 0.f, 0.f};
    bf16x8 At[4][2], B0[2][2], B1[2][2];
    const char* cA = (const char*)g.A + (size_t)cur.pm * tstepA; const char* cB = (const char*)g.Bt + (size_t)cur.pn * tstepB;
    S.a_ready(cur);
    if constexpr (SP2) {
        PG8_STAGE(PG8_SB(0, 0), cB, voffB); PG8_STAGE(PG8_SB(0, 1), cB + hstepB, voffB); PG8_STAGE(PG8_SA(0, 0), cA, voffA); PG8_STAGE(PG8_SA(0, 1), cA + hstepA, voffA);
        if (wr == 1) PG8_BAR;
        PG8_WAIT_V(2); PG8_BAR;
        PG8_STAGE(PG8_SB(1, 0), cB + kstep, voffB); PG8_STAGE(PG8_SA(1, 0), cA + PG8_AK(1), voffA); PG8_STAGE(PG8_SB(1, 1), cB + hstepB + kstep, voffB);
        PG8_WAIT_V(6); PG8_BAR;
    } else {
        PG8_STAGE(PG8_SB(0, 0), cB, voffB); PG8_STAGE(PG8_SA(0, 0), cA, voffA); PG8_STAGE(PG8_SB(0, 1), cB + hstepB, voffB); PG8_STAGE(PG8_SA(0, 1), cA + hstepA, voffA);
        if (wr == 1) PG8_BAR;
        PG8_WAIT_V(4); PG8_BAR;
        PG8_STAGE(PG8_SB(1, 0), cB + kstep, voffB); PG8_STAGE(PG8_SA(1, 0), cA + PG8_AK(1), voffA); PG8_STAGE(PG8_SB(1, 1), cB + hstepB + kstep, voffB);
        PG8_WAIT_V(6); PG8_BAR;
    }
    for (;;) {
        const bool has_next = S.next(ui + 1, nxt);
        const char* nA = has_next ? (const char*)g.A + (size_t)nxt.pm * tstepA : cA; const char* nB = has_next ? (const char*)g.Bt + (size_t)nxt.pn * tstepB : cB;
        for (int t = 0; t < nt; t += 2) {
            const bool last = (t == nt - 2);
            const char* a1 = cA + PG8_AK(t + 1);
            const char* a2 = last ? nA : cA + PG8_AK(t + 2); const char* b2 = last ? nB : cB + (size_t)(t + 2) * kstep;
            const char* a3 = last ? nA + PG8_AK(1) : cA + PG8_AK(t + 3); const char* b3 = b2 + kstep;
            if (last && has_next) S.a_ready(nxt);
            if constexpr (SP2) {
            PG8_LDB(B0, 0, 0); PG8_LDB(B1, 0, 1); PG8_SCHED; PG8_LDA(At, 0, 0); PG8_STAGE(PG8_SA(1, 1), a1 + hstepA, voffA);
            PG8_WAIT_V(8); PG8_WAIT_L(0); PG8_BAR; PG8_MMA(0, 0, At, B0); PG8_MMA(0, 1, At, B1); PG8_BAR; PG8_SCHED;
            PG8_LDA(At, 0, 1); PG8_STAGE(PG8_SB(0, 0), b2, voffB); PG8_STAGE(PG8_SB(0, 1), b2 + hstepB, voffB); PG8_STAGE(PG8_SA(0, 0), a2, voffA);
            PG8_WAIT_V(8); PG8_WAIT_L(0); PG8_BAR; PG8_MMA(1, 0, At, B0); PG8_MMA(1, 1, At, B1); PG8_BAR; PG8_SCHED;
            PG8_LDB(B0, 1, 0); PG8_LDB(B1, 1, 1); PG8_SCHED; PG8_LDA(At, 1, 0); PG8_STAGE(PG8_SA(0, 1), a2 + hstepA, voffA);
            PG8_WAIT_V(8); PG8_WAIT_L(0); PG8_BAR; PG8_MMA(0, 0, At, B0); PG8_MMA(0, 1, At, B1); PG8_BAR; PG8_SCHED;
            PG8_LDA(At, 1, 1); PG8_STAGE(PG8_SB(1, 0), b3, voffB); PG8_STAGE(PG8_SB(1, 1), b3 + hstepB, voffB); PG8_STAGE(PG8_SA(1, 0), a3, voffA);
            PG8_WAIT_V(8); PG8_WAIT_L(0); PG8_BAR; PG8_MMA(1, 0, At, B0); PG8_MMA(1, 1, At, B1); PG8_BAR; PG8_SCHED;
            } else {
            PG8_LDB(B0, 0, 0); PG8_SCHED; PG8_LDA(At, 0, 0); PG8_STAGE(PG8_SA(1, 1), a1 + hstepA, voffA);
            PG8_WAIT_L(8); PG8_BAR; PG8_WAIT_L(0); PG8_MMA(0, 0, At, B0); PG8_BAR; PG8_SCHED;
            PG8_LDB(B1, 0, 1); PG8_STAGE(PG8_SB(0, 0), b2, voffB);
            PG8_BAR; PG8_WAIT_L(0); PG8_MMA(0, 1, At, B1); PG8_BAR;
            PG8_LDA(At, 0, 1); PG8_STAGE(PG8_SA(0, 0), a2, voffA);
            PG8_BAR; PG8_WAIT_L(0); PG8_MMA(1, 0, At, B0); PG8_BAR; PG8_SCHED;
            PG8_STAGE(PG8_SB(0, 1), b2 + hstepB, voffB);
            PG8_WAIT_V(6); PG8_BAR; PG8_MMA(1, 1, At, B1); PG8_BAR;
            PG8_LDB(B0, 1, 0); PG8_SCHED; PG8_LDA(At, 1, 0); PG8_STAGE(PG8_SA(0, 1), a2 + hstepA, voffA);
            PG8_WAIT_L(8); PG8_BAR; PG8_WAIT_L(0); PG8_MMA(0, 0, At, B0); PG8_BAR; PG8_SCHED;
            PG8_LDB(B1, 1, 1); PG8_STAGE(PG8_SB(1, 0), b3, voffB);
            PG8_BAR; PG8_WAIT_L(0); PG8_MMA(0, 1, At, B1); PG8_BAR;
            PG8_LDA(At, 1, 1); PG8_STAGE(PG8_SA(1, 0), a3, voffA);
            PG8_BAR; PG8_WAIT_L(0); PG8_MMA(1, 0, At, B0); PG8_BAR; PG8_SCHED;
            PG8_STAGE(PG8_SB(1, 1), b3 + hstepB, voffB);
            PG8_WAIT_V(6); PG8_BAR; PG8_MMA(1, 1, At, B1); PG8_BAR;
            }
        }
        if constexpr (ALIGN_EPI) { if (wr == 0) PG8_BAR; }
        if constexpr (!Epi::AFTER_DRAIN) { E(acc, cur, wr, wc, fr, fq); S.done(cur); }
        if (!has_next) break;
#pragma unroll
        for (int a = 0; a < 2; ++a)
#pragma unroll
            for (int b = 0; b < 2; ++b)
#pragma unroll
                for (int m = 0; m < 4; ++m)
#pragma unroll
                    for (int n = 0; n < 2; ++n) acc[a][b][m][n] = (f32x4){0.f, 0.f, 0.f, 0.f};
        cur = nxt; cA = nA; cB = nB; ++ui;
        if constexpr (ALIGN_EPI) { if (wr == 1) PG8_BAR; }
    }
    PG8_WAIT_V(0);
    if constexpr (!ALIGN_EPI) { if (wr == 0) PG8_BAR; }
    PG8_BAR;
#undef PG8_AK
#undef PG8_SA
#undef PG8_SB
#undef PG8_STAGE
#undef PG8_LDA
#undef PG8_LDB
#undef PG8_MMA
#undef PG8_WAIT_V
#undef PG8_WAIT_L
#undef PG8_BAR
#undef PG8_SCHED
}
}

constexpr int NWAVES = 8;
constexpr int NB = 4, SEQ = 4096, DM = 1024, NMETA = 16;
constexpr int MREAL = NB * SEQ;
constexpr int MROWS = MREAL + NMETA;
constexpr int M1 = 16640;
constexpr int NPROJ = 6672, LDP = 6912;
constexpr int Q0 = 0, F0 = 1024, I0 = 2048, G0 = 3072, Z0 = 4096, XBC0 = 5120, DT0 = 6656;
constexpr int DFF = 2816, NUP = 2 * DFF;
constexpr float EPS = 1e-6f;

constexpr size_t MiB = 1u << 20;
constexpr size_t WS_CTL = 0, CTL_ZERO_BYTES = 1 * MiB;
constexpr size_t WS_WTOUT = 1 * MiB;
constexpr size_t WS_WTUP = 5 * MiB;
constexpr size_t WS_WTDN = 16 * MiB;
constexpr size_t WS_SSQ = 22 * MiB;
constexpr size_t WS_RSS = 23 * MiB + 512 * 1024;
constexpr size_t WS_MIXMETA = 24 * MiB + 512 * 1024;
constexpr size_t WS_H2M = WS_MIXMETA + 64 * 1024;
constexpr size_t WS_PMETA = WS_H2M + 16 * 1024;
constexpr size_t WS_HALO = 25 * MiB;
constexpr size_t WS_PROJ = 31 * MiB;
constexpr size_t WS_END = WS_PROJ + (size_t)M1 * LDP * 2;
static_assert(WS_END <= 256 * MiB, "d_ws map");
constexpr size_t DO_U = 0, DO_WTIN = 34 * MiB;
static_assert(DO_WTIN + (size_t)LDP * DM * 2 <= 64 * MiB && (size_t)M1 * DM * 2 <= DO_WTIN, "d_out scratch map");
constexpr int CW_BAR = 4096;

constexpr int RING_OFF = 0, RING_BYTES = 131072;
constexpr int LDSCTL_OFF = RING_BYTES, MISC_OFF = LDSCTL_OFF + 320;
constexpr int LDS_BYTES = 147456;

#define GAS __attribute__((address_space(1)))
#define LAS __attribute__((address_space(3)))
typedef unsigned short bf16;
typedef unsigned v4u __attribute__((ext_vector_type(4)));
typedef float f32x4 __attribute__((ext_vector_type(4)));
typedef short bf16x8 __attribute__((ext_vector_type(8)));
typedef GAS unsigned gu32;
#define RLX_AGENT __ATOMIC_RELAXED, __HIP_MEMORY_SCOPE_AGENT
#define LDS_WAIT() asm volatile("s_waitcnt lgkmcnt(0)" ::: "memory")
#define VM_WAIT() asm volatile("s_waitcnt vmcnt(0)" ::: "memory")
__device__ __forceinline__ unsigned f2bf(float f) { unsigned u = __builtin_bit_cast(unsigned, f); return (u + 0x7fffu + ((u >> 16) & 1u)) >> 16; }
__device__ __forceinline__ unsigned pk2(float lo, float hi) { return f2bf(lo) | (f2bf(hi) << 16); }
__device__ __forceinline__ float bf2f(unsigned short b) { return __builtin_bit_cast(float, ((unsigned)b) << 16); }
__device__ __forceinline__ float bflo(unsigned w) { return __builtin_bit_cast(float, w << 16); }
__device__ __forceinline__ float bfhi(unsigned w) { return __builtin_bit_cast(float, w & 0xffff0000u); }
__device__ __forceinline__ float sigmoidf_(float x) { return 1.0f / (1.0f + __expf(-x)); }
__device__ __forceinline__ float siluf_(float x) { return x / (1.0f + __expf(-x)); }
__device__ __forceinline__ float softplusf_(float x) { return x > 20.f ? x : log1pf(__expf(x)); }

#define XB_TMO      128
#define XB_XCNT(j)  (256  + 64 * (j))
#define XB_XSUB(j)  (1280 + 64 * (j))
#define XB_XGEN(j)  (2304 + 64 * (j))
#define XB_TOP      3328
#define XB_TOPGEN   3392
#define XCD_BAR_WORDS 3456
#define XB_SPIN_CAP (1u << 18)
__device__ __forceinline__ unsigned xb_ld(unsigned* p)              { return __hip_atomic_load(p, __ATOMIC_RELAXED, __HIP_MEMORY_SCOPE_AGENT); }
__device__ __forceinline__ unsigned xb_add(unsigned* p, unsigned v) { return __hip_atomic_fetch_add(p, v, __ATOMIC_RELAXED, __HIP_MEMORY_SCOPE_AGENT); }
__device__ __forceinline__ unsigned xb_xcc_id() { return (unsigned)__builtin_amdgcn_s_getreg((3 << 11) | 20) & 0xFu; }
#define XB_SPIN(cond, bar) do { unsigned _sp = 0; while (cond) { __builtin_amdgcn_s_sleep(1); \
    if ((++_sp & 255u) == 0u) { if (xb_ld(&(bar)[XB_TMO])) break; if (_sp > XB_SPIN_CAP) { atomicAdd(&(bar)[XB_TMO], 1u); break; } } } } while (0)
struct XcdBarrier { unsigned* bar; unsigned x; volatile LAS unsigned* st; };
__device__ __forceinline__ XcdBarrier xcd_barrier_post(unsigned* bar, volatile LAS unsigned* st) {
    XcdBarrier b; b.bar = bar; b.x = xb_xcc_id(); b.st = st;
    if (threadIdx.x == 0) (void)xb_add(&bar[XB_XCNT(b.x)], 1u);
    return b;
}
__device__ __forceinline__ void xcd_barrier_complete(unsigned* bar, unsigned x, unsigned& nloc, unsigned& nx) {
    const unsigned G = gridDim.x * gridDim.y * gridDim.z;
    unsigned sum, cnt, mine, sp = 0u;
    for (;;) {
        sum = 0u; cnt = 0u; mine = 0u;
#pragma unroll
        for (unsigned j = 0; j < 16; ++j) { const unsigned c = xb_ld(&bar[XB_XCNT(j)]); sum += c; cnt += (c > 0u) ? 1u : 0u; mine = (j == x) ? c : mine; }
        if (sum == G) break;
        __builtin_amdgcn_s_sleep(1);
        if ((++sp & 255u) == 0u) { if (xb_ld(&bar[XB_TMO])) break; if (sp > XB_SPIN_CAP) { atomicAdd(&bar[XB_TMO], 1u); break; } }
    }
    nloc = mine > 0u ? mine : 1u; nx = cnt > 0u ? cnt : 1u;
}
__device__ __forceinline__ void xcd_barrier(const XcdBarrier& b) {
    asm volatile("s_waitcnt vmcnt(0)" ::: "memory");
    __syncthreads();
    if (threadIdx.x == 0) {
        unsigned* bar = b.bar;
        __builtin_amdgcn_s_waitcnt(0);
        unsigned nloc = b.st[0], nx = b.st[1];
        if (nloc == 0u) { xcd_barrier_complete(bar, b.x, nloc, nx); b.st[0] = nloc; b.st[1] = nx; }
        const unsigned old = xb_add(&bar[XB_XSUB(b.x)], 1u);
        const unsigned gen = old / nloc;
        if (old + 1u == (gen + 1u) * nloc) {
            __builtin_amdgcn_fence(__ATOMIC_RELEASE, "agent");
            asm volatile("s_waitcnt vmcnt(0)" ::: "memory");
            const unsigned og = xb_add(&bar[XB_TOP], 1u);
            const unsigned tg = og / nx;
            if (og + 1u == (tg + 1u) * nx) xb_add(&bar[XB_TOPGEN], 1u);
            else XB_SPIN(xb_ld(&bar[XB_TOPGEN]) == tg, bar);
            __builtin_amdgcn_fence(__ATOMIC_ACQUIRE, "agent");
            xb_add(&bar[XB_XGEN(b.x)], 1u);
            asm volatile("s_waitcnt vmcnt(0)" ::: "memory");
        } else {
            XB_SPIN(xb_ld(&bar[XB_XGEN(b.x)]) == gen, bar);
            __builtin_amdgcn_fence(__ATOMIC_ACQUIRE, "agent");
            asm volatile("s_waitcnt vmcnt(0)" ::: "memory");
        }
    }
    __syncthreads();
}

struct Args { const float* in[19]; float* out; unsigned char* ws; int ph_lo, ph_hi; };
enum { IN_X = 0, IN_META, IN_N1W, IN_WIN, IN_LBL, IN_HGNW, IN_CW, IN_CB, IN_DTB, IN_ALOG, IN_D, IN_M2NW, IN_WOUT, IN_N2W, IN_WUP, IN_FCW, IN_FCB, IN_WDN, IN_FNW };

struct Frame {
    LAS unsigned char* lds;
    int tid, lane, wave, vcu, G;
};

__device__ __forceinline__ float wave_sum(float v) {
#pragma unroll
    for (int o = 1; o < 64; o <<= 1) v += __shfl_xor(v, o);
    return v;
}

__device__ __forceinline__ void p0_transpose_item(const float* W, int K, int N, int nvalid, bf16* WT, int drow0, int scol0, int k0, const float* kscale, LAS float* scr, int lane) {
    const int c = scol0 + (lane & 31);
#pragma unroll 8
    for (int i = 0; i < 32; ++i) { const int kk = 2 * i + (lane >> 5); float v = (c < nvalid) ? W[(size_t)(k0 + kk) * N + c] : 0.f; if (kscale) v *= kscale[k0 + kk]; scr[kk * 33 + (lane & 31)] = v; }
    LDS_WAIT(); asm volatile("" ::: "memory");
    const int ch = lane & 7;
#pragma unroll
    for (int j = 0; j < 4; ++j) { const int n = (lane >> 3) + 8 * j; const LAS float* s = scr + (8 * ch) * 33 + n;
        v4u o; o.x = pk2(s[0 * 33], s[1 * 33]); o.y = pk2(s[2 * 33], s[3 * 33]); o.z = pk2(s[4 * 33], s[5 * 33]); o.w = pk2(s[6 * 33], s[7 * 33]);
        *(GAS v4u*)(WT + (size_t)(drow0 + n) * K + k0 + 8 * ch) = o; }
    LDS_WAIT(); asm volatile("" ::: "memory");
}
__device__ __forceinline__ void rms_row_to_bf16(int lane, const float* xrow, const float* w, bf16* orow) {
    GAS unsigned long long* o8 = (GAS unsigned long long*)orow + lane;
    if (xrow == nullptr) {
#pragma unroll
        for (int j = 0; j < 4; ++j) o8[64 * j] = 0ull;
        return; }
    const GAS f32x4* xr = (const GAS f32x4*)xrow + lane; const GAS f32x4* wr = (const GAS f32x4*)w + lane;
    f32x4 v[4]; float s = 0.f;
#pragma unroll
    for (int j = 0; j < 4; ++j) { v[j] = xr[64 * j]; s += (v[j].x * v[j].x + v[j].y * v[j].y) + (v[j].z * v[j].z + v[j].w * v[j].w); }
    const float rs = 1.f / sqrtf(wave_sum(s) * (1.f / DM) + EPS);
#pragma unroll
    for (int j = 0; j < 4; ++j) { const f32x4 ww = wr[64 * j]; o8[64 * j] = (unsigned long long)pk2(v[j].x * rs * ww.x, v[j].y * rs * ww.y) | ((unsigned long long)pk2(v[j].z * rs * ww.z, v[j].w * rs * ww.w) << 32); }
}

__device__ __forceinline__ void p0_prologue(const Frame& F, const Args& a) {
    LAS float* scr = (LAS float*)(F.lds + RING_OFF + F.wave * 16384);
    const int gw = F.vcu * NWAVES + F.wave, NGW = F.G * NWAVES;
    bf16* WTin = (bf16*)((unsigned char*)a.out + DO_WTIN); bf16* WTout = (bf16*)(a.ws + WS_WTOUT); bf16* WTup = (bf16*)(a.ws + WS_WTUP); bf16* WTdn = (bf16*)(a.ws + WS_WTDN);
    constexpr int I_IN = (LDP / 32) * (DM / 64), I_OUT = (DM / 32) * (2048 / 64), I_UP = (NUP / 32) * (DM / 64), I_DN = (DM / 32) * (DFF / 64);
    constexpr int NITEMS = I_IN + I_OUT + I_UP + I_DN;
    for (int it = gw; it < NITEMS; it += NGW) {
        int r = it;
        if (r < I_IN) { const int nb = r % (LDP / 32), kb = r / (LDP / 32); p0_transpose_item(a.in[IN_WIN], DM, NPROJ, NPROJ, WTin, nb * 32, nb * 32, kb * 64, nullptr, scr, F.lane); continue; } r -= I_IN;
        if (r < I_OUT) { const int nb = r % (DM / 32), kb = r / (DM / 32); p0_transpose_item(a.in[IN_WOUT], 2048, DM, DM, WTout, nb * 32, nb * 32, kb * 64, nullptr, scr, F.lane); continue; } r -= I_OUT;
        if (r < I_UP) { const int nb = r % (NUP / 32), kb = r / (NUP / 32); const int d0 = nb * 32, pn = d0 >> 8, rem = d0 & 255, bj = rem >> 7, j = rem & 127;
            p0_transpose_item(a.in[IN_WUP], DM, NUP, NUP, WTup, d0, bj * DFF + pn * 128 + j, kb * 64, a.in[IN_N2W], scr, F.lane); continue; } r -= I_UP;
        { const int nb = r % (DM / 32), kb = r / (DM / 32); p0_transpose_item(a.in[IN_WDN], DFF, DM, DM, WTdn, nb * 32, nb * 32, kb * 64, nullptr, scr, F.lane); }
    }
    bf16* U = (bf16*)((unsigned char*)a.out + DO_U);
    for (int m = gw; m < M1; m += NGW) {
        const float* src = (m < MREAL) ? a.in[IN_X] + (size_t)m * DM : (m < MROWS ? a.in[IN_META] + (size_t)(m - MREAL) * DM : nullptr);
        rms_row_to_bf16(F.lane, src, a.in[IN_N1W], U + (size_t)m * DM);
    }
}

__device__ __forceinline__ void p4_groupnorm(const Frame& F, const Args& a) {
    const int gw = F.vcu * NWAVES + F.wave, NGW = F.G * NWAVES;
    bf16* proj = (bf16*)(a.ws + WS_PROJ); bf16* mixmeta = (bf16*)(a.ws + WS_MIXMETA); const float* ssq = (const float*)(a.ws + WS_SSQ);
    for (int m = gw; m < MROWS; m += NGW) {
        bf16* p = (m < MREAL) ? proj + (size_t)m * LDP + Z0 : mixmeta + (size_t)(m - MREAL) * 2048 + 1024;
        const int g = F.lane >> 5; const f32x4* sp = (const f32x4*)(ssq + (size_t)m * 16 + g * 8); const f32x4 s0 = sp[0], s1 = sp[1];
        const float tot = ((s0[0] + s0[1]) + (s0[2] + s0[3])) + ((s1[0] + s1[1]) + (s1[2] + s1[3]));
        const float sc = 1.f / sqrtf(tot * (1.f / 512.f) + EPS);
        v4u* q = (v4u*)(p + F.lane * 16);
#pragma unroll
        for (int j = 0; j < 2; ++j) { v4u w = q[j]; v4u o;
            o.x = pk2(bflo(w.x) * sc, bfhi(w.x) * sc); o.y = pk2(bflo(w.y) * sc, bfhi(w.y) * sc); o.z = pk2(bflo(w.z) * sc, bfhi(w.z) * sc); o.w = pk2(bflo(w.w) * sc, bfhi(w.w) * sc); q[j] = o; }
    }
}
__device__ __forceinline__ float wave_dot_bf16(const bf16* x, const bf16* w, int n, int lane) {
    float s = 0.f;
    for (int i = lane * 8; i < n; i += 512) { const v4u a = *(const v4u*)(x + i), b = *(const v4u*)(w + i);
        s += bflo(a.x) * bflo(b.x) + bfhi(a.x) * bfhi(b.x) + bflo(a.y) * bflo(b.y) + bfhi(a.y) * bfhi(b.y) + bflo(a.z) * bflo(b.z) + bfhi(a.z) * bfhi(b.z) + bflo(a.w) * bflo(b.w) + bfhi(a.w) * bfhi(b.w); }
    return wave_sum(s);
}
__device__ __forceinline__ void p5_meta_tail(const Frame& F, const Args& a) {
    const int gw = F.vcu * NWAVES + F.wave, NGW = F.G * NWAVES;
    const bf16* mixmeta = (const bf16*)(a.ws + WS_MIXMETA); const bf16* WTout = (const bf16*)(a.ws + WS_WTOUT); float* h2m = (float*)(a.ws + WS_H2M);
    for (int o = gw; o < 2 * DM; o += NGW) { const int i = o / DM, n = o % DM;
        const float d = wave_dot_bf16(mixmeta + (size_t)(14 + i) * 2048, WTout + (size_t)n * 2048, 2048, F.lane);
        if (F.lane == 0) h2m[o] = a.in[IN_META][(size_t)(14 + i) * DM + n] + d; }
}
__device__ __forceinline__ void p6_meta_tail(const Frame& F, const Args& a) {
    const int gw = F.vcu * NWAVES + F.wave, NGW = F.G * NWAVES;
    const bf16* WTup = (const bf16*)(a.ws + WS_WTUP); const float* h2m = (const float*)(a.ws + WS_H2M); float* pmeta = (float*)(a.ws + WS_PMETA);
    for (int o = gw; o < 2 * NUP; o += NGW) { const int i = o / NUP, c = o % NUP; const int isv = c >= DFF, cc = isv ? c - DFF : c, n = (cc >> 7) * 256 + isv * 128 + (cc & 127);
        const float* h = h2m + (size_t)i * DM; const bf16* w = WTup + (size_t)n * DM; float s = 0.f, ss = 0.f;
        for (int k = F.lane * 8; k < DM; k += 512) { const f32x4 h0 = *(const f32x4*)(h + k), h1 = *(const f32x4*)(h + k + 4); const v4u b = *(const v4u*)(w + k);
            ss += (h0[0] * h0[0] + h0[1] * h0[1]) + (h0[2] * h0[2] + h0[3] * h0[3]) + (h1[0] * h1[0] + h1[1] * h1[1]) + (h1[2] * h1[2] + h1[3] * h1[3]);
            s += bf2f(f2bf(h0[0])) * bflo(b.x) + bf2f(f2bf(h0[1])) * bfhi(b.x) + bf2f(f2bf(h0[2])) * bflo(b.y) + bf2f(f2bf(h0[3])) * bfhi(b.y)
               + bf2f(f2bf(h1[0])) * bflo(b.z) + bf2f(f2bf(h1[1])) * bfhi(b.z) + bf2f(f2bf(h1[2])) * bflo(b.w) + bf2f(f2bf(h1[3])) * bfhi(b.w); }
        s = wave_sum(s); ss = wave_sum(ss);
        if (F.lane == 0) pmeta[o] = s / sqrtf(ss * (1.f / DM) + EPS); }
}
__device__ __forceinline__ void p7_conv_glu(const Frame& F, const Args& a) {
    bf16* proj = (bf16*)(a.ws + WS_PROJ); const bf16* halo = (const bf16*)(a.ws + WS_HALO); const float* pmeta = (const float*)(a.ws + WS_PMETA);
    const float* cw = a.in[IN_FCW]; const float* cb = a.in[IN_FCB];
    constexpr int CG = DFF / 8;
    const int NT = F.G * NWAVES * 64;
    for (int it = (F.vcu * NWAVES + F.wave) * 64 + F.lane; it < 256 * CG; it += NT) {
        const int rb = it / CG, c0 = (it % CG) * 8;
        const int vcol = (c0 < 1024) ? c0 : c0 + 3840;
        float wg[3][8], wv[3][8], bg[8], bv[8], g2[8], g1[8], v2[8], v1[8];
#pragma unroll
        for (int k = 0; k < 3; ++k)
#pragma unroll
            for (int j = 0; j < 8; ++j) { wg[k][j] = cw[k * NUP + c0 + j]; wv[k][j] = cw[k * NUP + DFF + c0 + j]; }
#pragma unroll
        for (int j = 0; j < 8; ++j) { bg[j] = cb[c0 + j]; bv[j] = cb[DFF + c0 + j]; }
        if ((rb & 63) == 0) {
#pragma unroll
            for (int j = 0; j < 8; ++j) { g2[j] = pmeta[c0 + j]; v2[j] = pmeta[DFF + c0 + j]; g1[j] = pmeta[NUP + c0 + j]; v1[j] = pmeta[NUP + DFF + c0 + j]; }
        } else {
            const bf16* h = halo + (size_t)((rb - 1) * 2) * NUP;
            const v4u a0 = *(const v4u*)(h + c0), a1 = *(const v4u*)(h + DFF + c0), b0 = *(const v4u*)(h + NUP + c0), b1 = *(const v4u*)(h + NUP + DFF + c0);
            g2[0] = bflo(a0.x); g2[1] = bfhi(a0.x); g2[2] = bflo(a0.y); g2[3] = bfhi(a0.y); g2[4] = bflo(a0.z); g2[5] = bfhi(a0.z); g2[6] = bflo(a0.w); g2[7] = bfhi(a0.w);
            v2[0] = bflo(a1.x); v2[1] = bfhi(a1.x); v2[2] = bflo(a1.y); v2[3] = bfhi(a1.y); v2[4] = bflo(a1.z); v2[5] = bfhi(a1.z); v2[6] = bflo(a1.w); v2[7] = bfhi(a1.w);
            g1[0] = bflo(b0.x); g1[1] = bfhi(b0.x); g1[2] = bflo(b0.y); g1[3] = bfhi(b0.y); g1[4] = bflo(b0.z); g1[5] = bfhi(b0.z); g1[6] = bflo(b0.w); g1[7] = bfhi(b0.w);
            v1[0] = bflo(b1.x); v1[1] = bfhi(b1.x); v1[2] = bflo(b1.y); v1[3] = bfhi(b1.y); v1[4] = bflo(b1.z); v1[5] = bfhi(b1.z); v1[6] = bflo(b1.w); v1[7] = bfhi(b1.w);
        }
        bf16* rowp = proj + (size_t)(rb * 64) * LDP;
#pragma unroll 2
        for (int r = 0; r < 64; ++r, rowp += LDP) {
            const v4u pg = *(const v4u*)(rowp + 2048 + c0), pv = *(const v4u*)(rowp + vcol);
            float g0[8], v0[8], o[8];
            g0[0] = bflo(pg.x); g0[1] = bfhi(pg.x); g0[2] = bflo(pg.y); g0[3] = bfhi(pg.y); g0[4] = bflo(pg.z); g0[5] = bfhi(pg.z); g0[6] = bflo(pg.w); g0[7] = bfhi(pg.w);
            v0[0] = bflo(pv.x); v0[1] = bfhi(pv.x); v0[2] = bflo(pv.y); v0[3] = bfhi(pv.y); v0[4] = bflo(pv.z); v0[5] = bfhi(pv.z); v0[6] = bflo(pv.w); v0[7] = bfhi(pv.w);
#pragma unroll
            for (int j = 0; j < 8; ++j) { const float ug = bg[j] + wg[0][j] * g2[j] + wg[1][j] * g1[j] + wg[2][j] * g0[j]; const float uv = bv[j] + wv[0][j] * v2[j] + wv[1][j] * v1[j] + wv[2][j] * v0[j];
                o[j] = siluf_(ug) * uv; g2[j] = g1[j]; g1[j] = g0[j]; v2[j] = v1[j]; v1[j] = v0[j]; }
            v4u w; w.x = pk2(o[0], o[1]); w.y = pk2(o[2], o[3]); w.z = pk2(o[4], o[5]); w.w = pk2(o[6], o[7]);
            *(v4u*)(rowp + 2048 + c0) = w;
        }
    }
}
__device__ __forceinline__ void p9_final_norm(const Frame& F, const Args& a) {
    const int gw = F.vcu * NWAVES + F.wave, NGW = F.G * NWAVES;
    const float* rss = (const float*)(a.ws + WS_SSQ); const f32x4* wv = (const f32x4*)a.in[IN_FNW] + F.lane;
    for (int m = gw; m < MREAL; m += NGW) {
        const f32x4* rp = (const f32x4*)(rss + (size_t)m * 16); const f32x4 sa = rp[0], sb = rp[1], sc_ = rp[2], sd = rp[3];
        const float tot = (((sa[0] + sa[1]) + (sa[2] + sa[3])) + ((sb[0] + sb[1]) + (sb[2] + sb[3]))) + (((sc_[0] + sc_[1]) + (sc_[2] + sc_[3])) + ((sd[0] + sd[1]) + (sd[2] + sd[3])));
        const float rs = 1.f / sqrtf(tot * (1.f / DM) + EPS);
        f32x4* o = (f32x4*)(a.out + (size_t)m * DM) + F.lane;
#pragma unroll
        for (int j = 0; j < 4; ++j) { const f32x4 v = o[64 * j], w = wv[64 * j]; o[64 * j] = v * rs * w; }
    }
}

__device__ __forceinline__ size_t pos_row(int b, int pos) { return pos < NMETA ? (size_t)(MREAL + pos) : (size_t)b * SEQ + (pos - NMETA); }

__device__ __forceinline__ void slow_hgrn2_body(const Args& a, LAS float* sm, int blk, int tid) {
    const int b = blk >> 3, h = blk & 7, v = tid & 127; const bool act = tid < 128;
    LAS float* sq = sm; LAS float* sf = sm + 128; LAS float* sk = sm + 256; LAS float* red = sm + 384;
    bf16* proj = (bf16*)(a.ws + WS_PROJ); bf16* mixmeta = (bf16*)(a.ws + WS_MIXMETA);
    const float l0 = a.in[IN_LBL][h * 128 + v], l1 = a.in[IN_LBL][1024 + h * 128 + v];
    const float lb = 1.f / (1.f + expf(l1 - l0));
    const float nw = a.in[IN_HGNW][h * 128 + v];
    float s[128];
#pragma unroll
    for (int k = 0; k < 128; ++k) s[k] = 0.f;
    for (int pos = 0; pos < NMETA + SEQ; ++pos) {
        bf16* pr = proj + pos_row(b, pos) * LDP + h * 128 + v;
        const float qp = bf2f(pr[Q0]), fp = bf2f(pr[F0]), iv = bf2f(pr[I0]), gv = bf2f(pr[G0]);
        const float f = lb + (1.f - lb) * sigmoidf_(fp);
        if (act) { sq[v] = siluf_(qp); sf[v] = f; sk[v] = 1.f - f; }
        __syncthreads();
        float o = 0.f;
#pragma unroll
        for (int k = 0; k < 128; ++k) { s[k] = sf[k] * s[k] + sk[k] * iv; o += sq[k] * s[k]; }
        const float ss = wave_sum(o * o);
        if (act && (v & 63) == 0) red[v >> 6] = ss;
        __syncthreads();
        const float tot = red[0] + red[1];
        const float on = o / sqrtf(tot * (1.f / 128.f) + EPS) * nw * siluf_(gv);
        if (!act) continue;
        if (pos >= NMETA) pr[Q0] = (bf16)f2bf(on);
        else if (b == 0) mixmeta[(size_t)pos * 2048 + h * 128 + v] = (bf16)f2bf(on);
    }
}

__device__ __forceinline__ void slow_mamba_body(const Args& a, LAS float* sm, int blk, int tid) {
    const int b = blk >> 4, hm = blk & 15, g = hm >> 3, p = tid & 63; const bool act = tid < 64;
    LAS float* sB = sm; LAS float* sC = sm + 128;
    bf16* proj = (bf16*)(a.ws + WS_PROJ); bf16* mixmeta = (bf16*)(a.ws + WS_MIXMETA); float* ssq = (float*)(a.ws + WS_SSQ);
    const float* cw = a.in[IN_CW]; const float* cb = a.in[IN_CB];
    const float A = -expf(a.in[IN_ALOG][hm]), Dh = a.in[IN_D][hm], dtb = a.in[IN_DTB][hm], nw = a.in[IN_M2NW][hm * 64 + p];
    float s[128];
#pragma unroll
    for (int n = 0; n < 128; ++n) s[n] = 0.f;
    const int ch[5] = { hm * 64 + p, 1024 + g * 128 + p, 1024 + g * 128 + 64 + p, 1280 + g * 128 + p, 1280 + g * 128 + 64 + p };
    for (int pos = 0; pos < NMETA + SEQ; ++pos) {
        float cv[5];
#pragma unroll
        for (int c = 0; c < 5; ++c) { float acc = cb[ch[c]];
#pragma unroll
            for (int k = 0; k < 4; ++k) { const int pp = pos - 3 + k; if (pp >= 0) acc += cw[k * 1536 + ch[c]] * bf2f(proj[pos_row(b, pp) * LDP + XBC0 + ch[c]]); }
            cv[c] = siluf_(acc); }
        const size_t row = pos_row(b, pos);
        const float dt = softplusf_(bf2f(proj[row * LDP + DT0 + hm]) + dtb), dec = expf(dt * A);
        const float xv = cv[0], xdt = xv * dt;
        if (act) { sB[p] = cv[1]; sB[p + 64] = cv[2]; sC[p] = cv[3]; sC[p + 64] = cv[4]; }
        __syncthreads();
        float y = 0.f;
#pragma unroll
        for (int n = 0; n < 128; ++n) { s[n] = dec * s[n] + sB[n] * xdt; y += sC[n] * s[n]; }
        y += Dh * xv;
        bf16* zp = proj + row * LDP + Z0 + hm * 64 + p;
        y *= siluf_(bf2f(*zp));
        const float ss = wave_sum(y * y);
        if (act) {
        if (pos >= NMETA || b == 0) { if (p == 0) ssq[row * 16 + hm] = ss; }
        if (pos >= NMETA) *zp = (bf16)f2bf(y * nw);
        else if (b == 0) mixmeta[(size_t)pos * 2048 + 1024 + hm * 64 + p] = (bf16)f2bf(y * nw);
        }
        __syncthreads();
    }
}

__global__ void __launch_bounds__(NWAVES * 64, 2) mk_fwd(Args args) {
    extern __shared__ __attribute__((aligned(16))) unsigned char lds[];
    Frame F;
    F.lds = (LAS unsigned char*)lds;
    F.tid = threadIdx.x; F.lane = F.tid & 63; F.wave = __builtin_amdgcn_readfirstlane(F.tid >> 6);
    F.G = gridDim.x; { const int bx = blockIdx.x; F.vcu = (F.G % 8 == 0) ? (bx % 8) * (F.G / 8) + bx / 8 : bx; }
    volatile LAS unsigned* MISC = (volatile LAS unsigned*)(F.lds + MISC_OFF);
    unsigned char* ws = args.ws;
    for (int u = F.tid; u < (LDS_BYTES - LDSCTL_OFF) / 4; u += NWAVES * 64) ((LAS unsigned*)(F.lds + LDSCTL_OFF))[u] = 0u;
    __syncthreads();
    const int lo = args.ph_lo, hi = args.ph_hi;
    const bool use_bar = (hi - lo) > 1;
    XcdBarrier bar; bar.bar = (unsigned*)(ws + WS_CTL) + CW_BAR; bar.x = 0; bar.st = nullptr;
    if (use_bar) bar = xcd_barrier_post((unsigned*)(ws + WS_CTL) + CW_BAR, MISC + 8);
#define IN(k) (lo <= (k) && (k) < hi)
#define SEAM(k) do { if (IN(k) && IN((k) + 1)) xcd_barrier(bar); } while (0)
    bf16* proj = (bf16*)(ws + WS_PROJ);

    if (IN(0)) { p0_prologue(F, args); SEAM(0); }
    if (IN(1)) {
        pg8::Gemm g{(const bf16*)((unsigned char*)args.out + DO_U), (const bf16*)((unsigned char*)args.out + DO_WTIN), M1, LDP, DM, DM, 1 << 30, 0};
        pg8::StaticOrder S; S.init(M1, LDP, F.G, (int)blockIdx.x);
        pg8::EpiBf16 E{proj, LDP};
        pg8::gemm_phase<pg8::EpiBf16, pg8::StaticOrder, true, true>(F.lds + RING_OFF, g, S, E);
        SEAM(1);
    }
    if (IN(2)) {
        if (blockIdx.x < 32) slow_hgrn2_body(args, (LAS float*)(F.lds + RING_OFF), (int)blockIdx.x, F.tid);
        else if (blockIdx.x < 96) slow_mamba_body(args, (LAS float*)(F.lds + RING_OFF), (int)blockIdx.x - 32, F.tid);
        if (IN(2) && IN(4)) xcd_barrier(bar);
    }
    if (IN(4)) { p4_groupnorm(F, args); SEAM(4); }
    if (IN(5)) {
        p5_meta_tail(F, args); VM_WAIT(); __syncthreads();
        pg8::Gemm g{proj, (const bf16*)(ws + WS_WTOUT), MREAL, DM, 2048, LDP, 16, (Z0 - 1024) * 2};
        pg8::StaticOrder S; S.init(MREAL, DM, F.G, (int)blockIdx.x);
        pg8::EpiResid<true> E{args.in[IN_X], args.out, proj + F0, LDP, (float*)(ws + WS_RSS)};
        pg8::gemm_phase<pg8::EpiResid<true>, pg8::StaticOrder, false, true>(F.lds + RING_OFF, g, S, E);
        SEAM(5);
    }
    if (IN(6)) {
        p6_meta_tail(F, args); VM_WAIT(); __syncthreads();
        pg8::Gemm g{proj + F0, (const bf16*)(ws + WS_WTUP), MREAL, NUP, DM, LDP, 1 << 30, 0};
        pg8::StaticOrder S; S.init(MREAL, NUP, F.G, (int)blockIdx.x);
        pg8::EpiUp E{proj, (const float*)(ws + WS_RSS), (bf16*)(ws + WS_HALO)};
        pg8::gemm_phase<pg8::EpiUp, pg8::StaticOrder, true, true>(F.lds + RING_OFF, g, S, E);
        SEAM(6);
    }
    if (IN(7)) { p7_conv_glu(F, args); SEAM(7); }
    if (IN(8)) {
        pg8::Gemm g{proj + 2048, (const bf16*)(ws + WS_WTDN), MREAL, DM, DFF, LDP, 1 << 30, 0};
        pg8::StaticOrder S; S.init(MREAL, DM, F.G, (int)blockIdx.x);
        pg8::EpiResid<false> E{args.out, args.out, nullptr, 0, (float*)(ws + WS_SSQ)};
        pg8::gemm_phase<pg8::EpiResid<false>, pg8::StaticOrder, false, true>(F.lds + RING_OFF, g, S, E);
        SEAM(8);
    }
    if (IN(9)) { p9_final_norm(F, args); }
#undef IN
#undef SEAM
}

extern "C" void kernel_launch(void* const* d_in, const int* in_sizes, int n_in, void* d_out, int out_size, void* d_ws, size_t ws_size, hipStream_t stream) {
    static int grid = 0;
    if (grid == 0) {
        if (n_in != 19 || in_sizes[0] != MREAL * DM || out_size != MREAL * DM || ws_size < WS_END) { fprintf(stderr, "kernel_launch: unexpected shapes (n_in %d, in0 %d, out %d, ws %zu); nothing launched\n", n_in, n_in > 0 ? in_sizes[0] : -1, out_size, ws_size); grid = -1; return; }
        int dev = 0, cus = 0;
        if (hipGetDevice(&dev) != hipSuccess || hipDeviceGetAttribute(&cus, hipDeviceAttributeMultiprocessorCount, dev) != hipSuccess) { grid = -1; return; }
        if (hipFuncSetAttribute((const void*)mk_fwd, hipFuncAttributeMaxDynamicSharedMemorySize, LDS_BYTES) != hipSuccess) { fprintf(stderr, "kernel_launch: hipFuncSetAttribute failed\n"); grid = -1; return; }
        (void)hipGetLastError();
        grid = cus;
    }
    if (grid < 0) return;
    if (hipMemsetAsync((char*)d_ws + WS_CTL, 0, CTL_ZERO_BYTES, stream) != hipSuccess) { fprintf(stderr, "kernel_launch: memset failed\n"); return; }
    Args a{};
    for (int i = 0; i < 19; ++i) a.in[i] = (const float*)d_in[i];
    a.out = (float*)d_out; a.ws = (unsigned char*)d_ws;
#if MK_PER_PHASE
    const int phases[] = {0, 1, 2, 4, 5, 6, 7, 8, 9};
    for (int ph : phases) {
        a.ph_lo = ph; a.ph_hi = ph + 1;
        hipLaunchKernelGGL(mk_fwd, dim3(grid), dim3(NWAVES * 64), LDS_BYTES, stream, a);
    }
#else
    a.ph_lo = 0; a.ph_hi = 10;
    hipLaunchKernelGGL(mk_fwd, dim3(grid), dim3(NWAVES * 64), LDS_BYTES, stream, a);
#endif
    const hipError_t le = hipPeekAtLastError();
    if (le != hipSuccess) fprintf(stderr, "kernel_launch: launch failed: %s\n", hipGetErrorName(le));
}
```

```cpp
#include <hip/hip_runtime.h>
#include <cstdio>
#include <cstdint>

#ifndef MK_PER_PHASE
#define MK_PER_PHASE 0
#endif
#ifndef MK_SLOW_HG
#define MK_SLOW_HG 0
#endif
#ifndef MK_SLOW_MB
#define MK_SLOW_MB 0
#endif

namespace pg8 {
#define PG8_LAS __attribute__((address_space(3)))
typedef unsigned short bf16_t;
typedef short bf16x8 __attribute__((ext_vector_type(8)));
typedef float f32x4 __attribute__((ext_vector_type(4)));
typedef unsigned u32x4 __attribute__((ext_vector_type(4)));
constexpr int BM = 256, BK = 64, HALF = 128, HTB = HALF * BK * 2  , STAGE_BYTES = 8 * HTB, NXCD = 8, WGM = 8;

__host__ __device__ __forceinline__ int lds_byte(int r, int c) { const int st = (r >> 4) * 2 + (c >> 5), rr = r & 15, cc = c & 31, ob = rr * 64 + cc * 2; return st * 1024 + (ob ^ (((ob >> 9) & 1) << 5)); }
__host__ __device__ __forceinline__ void stage_rc(int b, int& R, int& C) { const int st = b / 1024, sb = b % 1024, swz = sb ^ (((sb >> 9) & 1) << 5); R = (st >> 1) * 16 + swz / 64; C = (st & 1) * 32 + (swz % 64) / 2; }
__host__ __device__ __forceinline__ int perm32(int rho) { const int n = rho >> 4, i = rho & 15; return 8 * (i >> 2) + 4 * n + (i & 3); }

struct Unit { int pm, pn; };
struct Gemm { const bf16_t* A; const bf16_t* Bt; int M, N, K; int lda; int ksplit; int kjump; };

struct StaticOrder {
    int nM, nN, nwg, G, c;
    __host__ __device__ void init(int M, int N, int G_, int c_) { nM = M / BM; nN = N / BM; nwg = nM * nN; G = G_; c = c_; }
    __host__ __device__ bool next(int i, Unit& u) const {
        const long L = (long)i * G + c; if (L >= nwg) return false;
        int wgid = (int)L; { const int q = nwg / NXCD, r = nwg % NXCD, xcd = wgid % NXCD, off = wgid / NXCD; wgid = (xcd < r ? xcd * (q + 1) : r * (q + 1) + (xcd - r) * q) + off; }
        const int nig = WGM * nN, gid = wgid / nig, fm = gid * WGM, gsz = (nM - fm) < WGM ? (nM - fm) : WGM;
        u.pm = fm + ((wgid % nig) % gsz); u.pn = (wgid % nig) / gsz; return true;
    }
    __device__ __forceinline__ void a_ready(const Unit&) const {}
    __device__ __forceinline__ void done(const Unit&) const {}
};

__device__ __forceinline__ unsigned cvt_pk_bf16(float lo, float hi) { unsigned r; asm volatile("v_cvt_pk_bf16_f32 %0, %1, %2" : "=v"(r) : "v"(lo), "v"(hi)); return r; }
__device__ __forceinline__ u32x4 pack8(const f32x4 v0, const f32x4 v1) { u32x4 w; w.x = cvt_pk_bf16(v0[0], v0[1]); w.y = cvt_pk_bf16(v0[2], v0[3]); w.z = cvt_pk_bf16(v1[0], v1[1]); w.w = cvt_pk_bf16(v1[2], v1[3]); return w; }

struct EpiBf16 {
    static constexpr bool PERM = true, AFTER_DRAIN = false;
    bf16_t* O; int ldc;
    __device__ __forceinline__ void operator()(const f32x4 (&acc)[2][2][4][2], const Unit& u, int wr, int wc, int fr, int fq) const {
        const int row0 = u.pm * BM + wr * 64 + fr, col0 = u.pn * BM + wc * 32 + 8 * fq;
#pragma unroll
        for (int ai = 0; ai < 2; ++ai)
#pragma unroll
            for (int m = 0; m < 4; ++m) { bf16_t* rowp = O + (size_t)(row0 + ai * HALF + m * 16) * ldc + col0;
#pragma unroll
                for (int bj = 0; bj < 2; ++bj) *(u32x4*)(rowp + bj * HALF) = pack8(acc[ai][bj][m][0], acc[ai][bj][m][1]); }
    }
};
template <bool WRITE_A2> struct EpiResid {
    static constexpr bool PERM = true, AFTER_DRAIN = false;
    const float* base; float* out; bf16_t* a2; int lda2; float* rss;
    __device__ __forceinline__ void operator()(const f32x4 (&acc)[2][2][4][2], const Unit& u, int wr, int wc, int fr, int fq) const {
        const int row0 = u.pm * BM + wr * 64 + fr, col0 = u.pn * BM + wc * 32 + 8 * fq;
#pragma unroll
        for (int ai = 0; ai < 2; ++ai)
#pragma unroll
            for (int m = 0; m < 4; ++m) { const int row = row0 + ai * HALF + m * 16; float ss = 0.f;
#pragma unroll
                for (int bj = 0; bj < 2; ++bj) { const size_t o = (size_t)row * 1024 + col0 + bj * HALF;
                    const f32x4 v0 = acc[ai][bj][m][0] + *(const f32x4*)(base + o), v1 = acc[ai][bj][m][1] + *(const f32x4*)(base + o + 4);
                    *(f32x4*)(out + o) = v0; *(f32x4*)(out + o + 4) = v1;
                    ss += (v0[0] * v0[0] + v0[1] * v0[1]) + (v0[2] * v0[2] + v0[3] * v0[3]) + (v1[0] * v1[0] + v1[1] * v1[1]) + (v1[2] * v1[2] + v1[3] * v1[3]);
                    if (WRITE_A2) *(u32x4*)(a2 + (size_t)row * lda2 + col0 + bj * HALF) = pack8(v0, v1); }
                ss += __shfl_xor(ss, 16); ss += __shfl_xor(ss, 32);
                if (fq == 0) rss[(size_t)row * 16 + u.pn * 4 + wc] = ss; }
    }
};
struct EpiUp {
    static constexpr bool PERM = true, AFTER_DRAIN = false;
    bf16_t* proj; const float* rss; bf16_t* halo;
    __device__ __forceinline__ void operator()(const f32x4 (&acc)[2][2][4][2], const Unit& u, int wr, int wc, int fr, int fq) const {
        const int row0 = u.pm * BM + wr * 64 + fr, jc = u.pn * 128 + wc * 32 + 8 * fq;
        const int dcol[2] = { 2048 + jc, (u.pn < 8) ? jc : jc + 3840 };
#pragma unroll
        for (int ai = 0; ai < 2; ++ai)
#pragma unroll
            for (int m = 0; m < 4; ++m) { const int row = row0 + ai * HALF + m * 16;
                const f32x4* rp = (const f32x4*)(rss + (size_t)row * 16); const f32x4 a = rp[0], b = rp[1], c = rp[2], d = rp[3];
                const float tot = (((a[0] + a[1]) + (a[2] + a[3])) + ((b[0] + b[1]) + (b[2] + b[3]))) + (((c[0] + c[1]) + (c[2] + c[3])) + ((d[0] + d[1]) + (d[2] + d[3])));
                const float rs = 1.0f / sqrtf(tot * (1.0f / 1024.0f) + 1e-6f);
#pragma unroll
                for (int bj = 0; bj < 2; ++bj) { const u32x4 w = pack8(acc[ai][bj][m][0] * rs, acc[ai][bj][m][1] * rs);
                    *(u32x4*)(proj + (size_t)row * 6912 + dcol[bj]) = w;
                    if ((row & 63) >= 62) *(u32x4*)(halo + (size_t)((row >> 6) * 2 + (row & 1)) * 5632 + bj * 2816 + jc) = w; } }
    }
};

template <class Epi, class Sched, bool ALIGN_EPI = false, bool SP2 = false>
__device__ __forceinline__ void gemm_phase(PG8_LAS unsigned char* lds, const Gemm g, const Sched& S, const Epi& E) {
    const int tid = threadIdx.x, wid = __builtin_amdgcn_readfirstlane(tid >> 6), lane = tid & 63, wr = wid >> 2, wc = wid & 3, fr = lane & 15, fq = lane >> 4;
    const int K = g.K, nt = K / BK, lda = g.lda;
    unsigned voffA[2], voffB[2];
#pragma unroll
    for (int i = 0; i < 2; ++i) { int R, C; stage_rc(tid * 16 + i * 8192, R, C); const int Rb = Epi::PERM ? ((R & ~31) + perm32(R & 31)) : R;
        voffA[i] = (unsigned)(R * lda + C) * 2u; voffB[i] = (unsigned)(Rb * K + C) * 2u; }
    const size_t kstep = (size_t)(BK * 2);
    const size_t hstepA = (size_t)HALF * lda * 2, tstepA = 2 * hstepA;
    const size_t hstepB = (size_t)HALF * K * 2, tstepB = 2 * hstepB;
    const int ksplit = g.ksplit; const size_t kjump = (size_t)g.kjump;
#define PG8_AK(kt) ((size_t)(kt) * kstep + (((kt) >= ksplit) ? kjump : (size_t)0))
    const unsigned ldsw = (unsigned)wid * 1024u;
    const int aoff = lds_byte(wr * 64 + fr, fq * 8), boff = lds_byte(wc * 32 + fr, fq * 8);
#define PG8_SA(b, h) (((b) * 2 + (h)) * HTB)
#define PG8_SB(b, h) ((4 + (b) * 2 + (h)) * HTB)
#define PG8_STAGE(bufoff, gbase, voff) do { _Pragma("unroll") for (int _i = 0; _i < 2; ++_i) \
        __builtin_amdgcn_global_load_lds((const unsigned*)((const char*)(gbase) + (voff)[_i]), (PG8_LAS unsigned*)(lds + (bufoff) + ldsw + _i * 8192), 16, 0, 0); } while (0)
#define PG8_LDA(dst, b, h) do { _Pragma("unroll") for (int m = 0; m < 4; ++m) _Pragma("unroll") for (int k = 0; k < 2; ++k) dst[m][k] = *(const PG8_LAS bf16x8*)(lds + PG8_SA(b, h) + aoff + m * 2048 + k * 1024); } while (0)
#define PG8_LDB(dst, b, h) do { _Pragma("unroll") for (int n = 0; n < 2; ++n) _Pragma("unroll") for (int k = 0; k < 2; ++k) dst[n][k] = *(const PG8_LAS bf16x8*)(lds + PG8_SB(b, h) + boff + n * 2048 + k * 1024); } while (0)
#define PG8_MMA(ai, bj, At, Bt) do { __builtin_amdgcn_s_setprio(1); _Pragma("unroll") for (int m = 0; m < 4; ++m) _Pragma("unroll") for (int n = 0; n < 2; ++n) _Pragma("unroll") for (int k = 0; k < 2; ++k) \
        acc[ai][bj][m][n] = __builtin_amdgcn_mfma_f32_16x16x32_bf16(Bt[n][k], At[m][k], acc[ai][bj][m][n], 0, 0, 0); __builtin_amdgcn_s_setprio(0); } while (0)
#define PG8_WAIT_V(n) asm volatile("s_waitcnt vmcnt(" #n ")" ::: "memory")
#define PG8_WAIT_L(n) asm volatile("s_waitcnt lgkmcnt(" #n ")" ::: "memory")
#define PG8_BAR __builtin_amdgcn_s_barrier()
#define PG8_SCHED __builtin_amdgcn_sched_barrier(0)
    Unit cur, nxt; int ui = 0;
    if (!S.next(0, cur)) return;
    f32x4 acc[2][2][4][2];
#pragma unroll
    for (int a = 0; a < 2; ++a)
#pragma unroll
        for (int b = 0; b < 2; ++b)
#pragma unroll
            for (int m = 0; m < 4; ++m)
#pragma unroll
                for (int n = 0; n < 2; ++n) acc[a][b][m][n] = (f32x4){0.f, 0.f, 0.f, 0.f};
    bf16x8 At[4][2], B0[2][2], B1[2][2];
    const char* cA = (const char*)g.A + (size_t)cur.pm * tstepA; const char* cB = (const char*)g.Bt + (size_t)cur.pn * tstepB;
    S.a_ready(cur);
    if constexpr (SP2) {
        PG8_STAGE(PG8_SB(0, 0), cB, voffB); PG8_STAGE(PG8_SB(0, 1), cB + hstepB, voffB); PG8_STAGE(PG8_SA(0, 0), cA, voffA); PG8_STAGE(PG8_SA(0, 1), cA + hstepA, voffA);
        if (wr == 1) PG8_BAR;
        PG8_WAIT_V(2); PG8_BAR;
        PG8_STAGE(PG8_SB(1, 0), cB + kstep, voffB); PG8_STAGE(PG8_SA(1, 0), cA + PG8_AK(1), voffA); PG8_STAGE(PG8_SB(1, 1), cB + hstepB + kstep, voffB);
        PG8_WAIT_V(6); PG8_BAR;
    } else {
        PG8_STAGE(PG8_SB(0, 0), cB, voffB); PG8_STAGE(PG8_SA(0, 0), cA, voffA); PG8_STAGE(PG8_SB(0, 1), cB + hstepB, voffB); PG8_STAGE(PG8_SA(0, 1), cA + hstepA, voffA);
        if (wr == 1) PG8_BAR;
        PG8_WAIT_V(4); PG8_BAR;
        PG8_STAGE(PG8_SB(1, 0), cB + kstep, voffB); PG8_STAGE(PG8_SA(1, 0), cA + PG8_AK(1), voffA); PG8_STAGE(PG8_SB(1, 1), cB + hstepB + kstep, voffB);
        PG8_WAIT_V(6); PG8_BAR;
    }
    for (;;) {
        const bool has_next = S.next(ui + 1, nxt);
        const char* nA = has_next ? (const char*)g.A + (size_t)nxt.pm * tstepA : cA; const char* nB = has_next ? (const char*)g.Bt + (size_t)nxt.pn * tstepB : cB;
        for (int t = 0; t < nt; t += 2) {
            const bool last = (t == nt - 2);
            const char* a1 = cA + PG8_AK(t + 1);
            const char* a2 = last ? nA : cA + PG8_AK(t + 2); const char* b2 = last ? nB : cB + (size_t)(t + 2) * kstep;
            const char* a3 = last ? nA + PG8_AK(1) : cA + PG8_AK(t + 3); const char* b3 = b2 + kstep;
            if (last && has_next) S.a_ready(nxt);
            if constexpr (SP2) {
            PG8_LDB(B0, 0, 0); PG8_LDB(B1, 0, 1); PG8_SCHED; PG8_LDA(At, 0, 0); PG8_STAGE(PG8_SA(1, 1), a1 + hstepA, voffA);
            PG8_WAIT_V(8); PG8_WAIT_L(0); PG8_BAR; PG8_MMA(0, 0, At, B0); PG8_MMA(0, 1, At, B1); PG8_BAR; PG8_SCHED;
            PG8_LDA(At, 0, 1); PG8_STAGE(PG8_SB(0, 0), b2, voffB); PG8_STAGE(PG8_SB(0, 1), b2 + hstepB, voffB); PG8_STAGE(PG8_SA(0, 0), a2, voffA);
            PG8_WAIT_V(8); PG8_WAIT_L(0); PG8_BAR; PG8_MMA(1, 0, At, B0); PG8_MMA(1, 1, At, B1); PG8_BAR; PG8_SCHED;
            PG8_LDB(B0, 1, 0); PG8_LDB(B1, 1, 1); PG8_SCHED; PG8_LDA(At, 1, 0); PG8_STAGE(PG8_SA(0, 1), a2 + hstepA, voffA);
            PG8_WAIT_V(8); PG8_WAIT_L(0); PG8_BAR; PG8_MMA(0, 0, At, B0); PG8_MMA(0, 1, At, B1); PG8_BAR; PG8_SCHED;
            PG8_LDA(At, 1, 1); PG8_STAGE(PG8_SB(1, 0), b3, voffB); PG8_STAGE(PG8_SB(1, 1), b3 + hstepB, voffB); PG8_STAGE(PG8_SA(1, 0), a3, voffA);
            PG8_WAIT_V(8); PG8_WAIT_L(0); PG8_BAR; PG8_MMA(1, 0, At, B0); PG8_MMA(1, 1, At, B1); PG8_BAR; PG8_SCHED;
            } else {
            PG8_LDB(B0, 0, 0); PG8_SCHED; PG8_LDA(At, 0, 0); PG8_STAGE(PG8_SA(1, 1), a1 + hstepA, voffA);
            PG8_WAIT_L(8); PG8_BAR; PG8_WAIT_L(0); PG8_MMA(0, 0, At, B0); PG8_BAR; PG8_SCHED;
            PG8_LDB(B1, 0, 1); PG8_STAGE(PG8_SB(0, 0), b2, voffB);
            PG8_BAR; PG8_WAIT_L(0); PG8_MMA(0, 1, At, B1); PG8_BAR;
            PG8_LDA(At, 0, 1); PG8_STAGE(PG8_SA(0, 0), a2, voffA);
            PG8_BAR; PG8_WAIT_L(0); PG8_MMA(1, 0, At, B0); PG8_BAR; PG8_SCHED;
            PG8_STAGE(PG8_SB(0, 1), b2 + hstepB, voffB);
            PG8_WAIT_V(6); PG8_BAR; PG8_MMA(1, 1, At, B1); PG8_BAR;
            PG8_LDB(B0, 1, 0); PG8_SCHED; PG8_LDA(At, 1, 0); PG8_STAGE(PG8_SA(0, 1), a2 + hstepA, voffA);
            PG8_WAIT_L(8); PG8_BAR; PG8_WAIT_L(0); PG8_MMA(0, 0, At, B0); PG8_BAR; PG8_SCHED;
            PG8_LDB(B1, 1, 1); PG8_STAGE(PG8_SB(1, 0), b3, voffB);
            PG8_BAR; PG8_WAIT_L(0); PG8_MMA(0, 1, At, B1); PG8_BAR;
            PG8_LDA(At, 1, 1); PG8_STAGE(PG8_SA(1, 0), a3, voffA);
            PG8_BAR; PG8_WAIT_L(0); PG8_MMA(1, 0, At, B0); PG8_BAR; PG8_SCHED;
            PG8_STAGE(PG8_SB(1, 1), b3 + hstepB, voffB);
            PG8_WAIT_V(6); PG8_BAR; PG8_MMA(1, 1, At, B1); PG8_BAR;
            }
        }
        if constexpr (ALIGN_EPI) { if (wr == 0) PG8_BAR; }
        if constexpr (!Epi::AFTER_DRAIN) { E(acc, cur, wr, wc, fr, fq); S.done(cur); }
        if (!has_next) break;
#pragma unroll
        for (int a = 0; a < 2; ++a)
#pragma unroll
            for (int b = 0; b < 2; ++b)
#pragma unroll
                for (int m = 0; m < 4; ++m)
#pragma unroll
                    for (int n = 0; n < 2; ++n) acc[a][b][m][n] = (f32x4){0.f, 0.f, 0.f, 0.f};
        cur = nxt; cA = nA; cB = nB; ++ui;
        if constexpr (ALIGN_EPI) { if (wr == 1) PG8_BAR; }
    }
    PG8_WAIT_V(0);
    if constexpr (!ALIGN_EPI) { if (wr == 0) PG8_BAR; }
    PG8_BAR;
#undef PG8_AK
#undef PG8_SA
#undef PG8_SB
#undef PG8_STAGE
#undef PG8_LDA
#undef PG8_LDB
#undef PG8_MMA
#undef PG8_WAIT_V
#undef PG8_WAIT_L
#undef PG8_BAR
#undef PG8_SCHED
}
}

constexpr int NWAVES = 8;
constexpr int NB = 4, SEQ = 4096, DM = 1024, NMETA = 16;
constexpr int MREAL = NB * SEQ;
constexpr int MROWS = MREAL + NMETA;
constexpr int M1 = 16640;
constexpr int NPROJ = 6672, LDP = 6912;
constexpr int Q0 = 0, F0 = 1024, I0 = 2048, G0 = 3072, Z0 = 4096, XBC0 = 5120, DT0 = 6656;
constexpr int DFF = 2816, NUP = 2 * DFF;
constexpr float EPS = 1e-6f;

constexpr size_t MiB = 1u << 20;
constexpr size_t WS_CTL = 0, CTL_ZERO_BYTES = 1 * MiB;
constexpr size_t WS_WTOUT = 1 * MiB;
constexpr size_t WS_WTUP = 5 * MiB;
constexpr size_t WS_WTDN = 16 * MiB;
constexpr size_t WS_SSQ = 22 * MiB;
constexpr size_t WS_RSS = 23 * MiB + 512 * 1024;
constexpr size_t WS_MIXMETA = 24 * MiB + 512 * 1024;
constexpr size_t WS_H2M = WS_MIXMETA + 64 * 1024;
constexpr size_t WS_PMETA = WS_H2M + 16 * 1024;
constexpr size_t WS_HALO = 25 * MiB;
constexpr size_t WS_PROJ = 31 * MiB;
constexpr size_t WS_END = WS_PROJ + (size_t)M1 * LDP * 2;
static_assert(WS_END <= 256 * MiB, "d_ws map");
constexpr size_t DO_U = 0, DO_WTIN = 34 * MiB;
static_assert(DO_WTIN + (size_t)LDP * DM * 2 <= 64 * MiB && (size_t)M1 * DM * 2 <= DO_WTIN, "d_out scratch map");
constexpr int CW_BAR = 4096;

constexpr int RING_OFF = 0, RING_BYTES = 131072;
constexpr int LDSCTL_OFF = RING_BYTES, MISC_OFF = LDSCTL_OFF + 320;
constexpr int LDS_BYTES = 147456;

#define GAS __attribute__((address_space(1)))
#define LAS __attribute__((address_space(3)))
typedef unsigned short bf16;
typedef unsigned v4u __attribute__((ext_vector_type(4)));
typedef float f32x4 __attribute__((ext_vector_type(4)));
typedef short bf16x8 __attribute__((ext_vector_type(8)));
typedef GAS unsigned gu32;
#define RLX_AGENT __ATOMIC_RELAXED, __HIP_MEMORY_SCOPE_AGENT
#define LDS_WAIT() asm volatile("s_waitcnt lgkmcnt(0)" ::: "memory")
#define VM_WAIT() asm volatile("s_waitcnt vmcnt(0)" ::: "memory")
__device__ __forceinline__ unsigned f2bf(float f) { unsigned u = __builtin_bit_cast(unsigned, f); return (u + 0x7fffu + ((u >> 16) & 1u)) >> 16; }
__device__ __forceinline__ unsigned pk2(float lo, float hi) { return f2bf(lo) | (f2bf(hi) << 16); }
__device__ __forceinline__ float bf2f(unsigned short b) { return __builtin_bit_cast(float, ((unsigned)b) << 16); }
__device__ __forceinline__ float bflo(unsigned w) { return __builtin_bit_cast(float, w << 16); }
__device__ __forceinline__ float bfhi(unsigned w) { return __builtin_bit_cast(float, w & 0xffff0000u); }
__device__ __forceinline__ float sigmoidf_(float x) { return 1.0f / (1.0f + __expf(-x)); }
__device__ __forceinline__ float siluf_(float x) { return x / (1.0f + __expf(-x)); }
__device__ __forceinline__ float softplusf_(float x) { return x > 20.f ? x : log1pf(__expf(x)); }

#define XB_TMO      128
#define XB_XCNT(j)  (256  + 64 * (j))
#define XB_XSUB(j)  (1280 + 64 * (j))
#define XB_XGEN(j)  (2304 + 64 * (j))
#define XB_TOP      3328
#define XB_TOPGEN   3392
#define XCD_BAR_WORDS 3456
#define XB_SPIN_CAP (1u << 18)
__device__ __forceinline__ unsigned xb_ld(unsigned* p)              { return __hip_atomic_load(p, __ATOMIC_RELAXED, __HIP_MEMORY_SCOPE_AGENT); }
__device__ __forceinline__ unsigned xb_add(unsigned* p, unsigned v) { return __hip_atomic_fetch_add(p, v, __ATOMIC_RELAXED, __HIP_MEMORY_SCOPE_AGENT); }
__device__ __forceinline__ unsigned xb_xcc_id() { return (unsigned)__builtin_amdgcn_s_getreg((3 << 11) | 20) & 0xFu; }
#define XB_SPIN(cond, bar) do { unsigned _sp = 0; while (cond) { __builtin_amdgcn_s_sleep(1); \
    if ((++_sp & 255u) == 0u) { if (xb_ld(&(bar)[XB_TMO])) break; if (_sp > XB_SPIN_CAP) { atomicAdd(&(bar)[XB_TMO], 1u); break; } } } } while (0)
struct XcdBarrier { unsigned* bar; unsigned x; volatile LAS unsigned* st; };
__device__ __forceinline__ XcdBarrier xcd_barrier_post(unsigned* bar, volatile LAS unsigned* st) {
    XcdBarrier b; b.bar = bar; b.x = xb_xcc_id(); b.st = st;
    if (threadIdx.x == 0) (void)xb_add(&bar[XB_XCNT(b.x)], 1u);
    return b;
}
__device__ __forceinline__ void xcd_barrier_complete(unsigned* bar, unsigned x, unsigned& nloc, unsigned& nx) {
    const unsigned G = gridDim.x * gridDim.y * gridDim.z;
    unsigned sum, cnt, mine, sp = 0u;
    for (;;) {
        sum = 0u; cnt = 0u; mine = 0u;
#pragma unroll
        for (unsigned j = 0; j < 16; ++j) { const unsigned c = xb_ld(&bar[XB_XCNT(j)]); sum += c; cnt += (c > 0u) ? 1u : 0u; mine = (j == x) ? c : mine; }
        if (sum == G) break;
        __builtin_amdgcn_s_sleep(1);
        if ((++sp & 255u) == 0u) { if (xb_ld(&bar[XB_TMO])) break; if (sp > XB_SPIN_CAP) { atomicAdd(&bar[XB_TMO], 1u); break; } }
    }
    nloc = mine > 0u ? mine : 1u; nx = cnt > 0u ? cnt : 1u;
}
__device__ __forceinline__ void xcd_barrier(const XcdBarrier& b) {
    asm volatile("s_waitcnt vmcnt(0)" ::: "memory");
    __syncthreads();
    if (threadIdx.x == 0) {
        unsigned* bar = b.bar;
        __builtin_amdgcn_s_waitcnt(0);
        unsigned nloc = b.st[0], nx = b.st[1];
        if (nloc == 0u) { xcd_barrier_complete(bar, b.x, nloc, nx); b.st[0] = nloc; b.st[1] = nx; }
        const unsigned old = xb_add(&bar[XB_XSUB(b.x)], 1u);
        const unsigned gen = old / nloc;
        if (old + 1u == (gen + 1u) * nloc) {
            __builtin_amdgcn_fence(__ATOMIC_RELEASE, "agent");
            asm volatile("s_waitcnt vmcnt(0)" ::: "memory");
            const unsigned og = xb_add(&bar[XB_TOP], 1u);
            const unsigned tg = og / nx;
            if (og + 1u == (tg + 1u) * nx) xb_add(&bar[XB_TOPGEN], 1u);
            else XB_SPIN(xb_ld(&bar[XB_TOPGEN]) == tg, bar);
            __builtin_amdgcn_fence(__ATOMIC_ACQUIRE, "agent");
            xb_add(&bar[XB_XGEN(b.x)], 1u);
            asm volatile("s_waitcnt vmcnt(0)" ::: "memory");
        } else {
            XB_SPIN(xb_ld(&bar[XB_XGEN(b.x)]) == gen, bar);
            __builtin_amdgcn_fence(__ATOMIC_ACQUIRE, "agent");
            asm volatile("s_waitcnt vmcnt(0)" ::: "memory");
        }
    }
    __syncthreads();
}

struct Args { const float* in[19]; float* out; unsigned char* ws; int ph_lo, ph_hi; };
enum { IN_X = 0, IN_META, IN_N1W, IN_WIN, IN_LBL, IN_HGNW, IN_CW, IN_CB, IN_DTB, IN_ALOG, IN_D, IN_M2NW, IN_WOUT, IN_N2W, IN_WUP, IN_FCW, IN_FCB, IN_WDN, IN_FNW };

struct Frame {
    LAS unsigned char* lds;
    int tid, lane, wave, vcu, G;
};

__device__ __forceinline__ float wave_sum(float v) {
#pragma unroll
    for (int o = 1; o < 64; o <<= 1) v += __shfl_xor(v, o);
    return v;
}

__device__ __forceinline__ void p0_transpose_item(const float* W, int K, int N, int nvalid, bf16* WT, int drow0, int scol0, int k0, const float* kscale, LAS float* scr, int lane) {
    const int c = scol0 + (lane & 31);
#pragma unroll 8
    for (int i = 0; i < 32; ++i) { const int kk = 2 * i + (lane >> 5); float v = (c < nvalid) ? W[(size_t)(k0 + kk) * N + c] : 0.f; if (kscale) v *= kscale[k0 + kk]; scr[kk * 33 + (lane & 31)] = v; }
    LDS_WAIT(); asm volatile("" ::: "memory");
    const int ch = lane & 7;
#pragma unroll
    for (int j = 0; j < 4; ++j) { const int n = (lane >> 3) + 8 * j; const LAS float* s = scr + (8 * ch) * 33 + n;
        v4u o; o.x = pk2(s[0 * 33], s[1 * 33]); o.y = pk2(s[2 * 33], s[3 * 33]); o.z = pk2(s[4 * 33], s[5 * 33]); o.w = pk2(s[6 * 33], s[7 * 33]);
        *(GAS v4u*)(WT + (size_t)(drow0 + n) * K + k0 + 8 * ch) = o; }
    LDS_WAIT(); asm volatile("" ::: "memory");
}
__device__ __forceinline__ void rms_row_to_bf16(int lane, const float* xrow, const float* w, bf16* orow) {
    GAS unsigned long long* o8 = (GAS unsigned long long*)orow + lane;
    if (xrow == nullptr) {
#pragma unroll
        for (int j = 0; j < 4; ++j) o8[64 * j] = 0ull;
        return; }
    const GAS f32x4* xr = (const GAS f32x4*)xrow + lane; const GAS f32x4* wr = (const GAS f32x4*)w + lane;
    f32x4 v[4]; float s = 0.f;
#pragma unroll
    for (int j = 0; j < 4; ++j) { v[j] = xr[64 * j]; s += (v[j].x * v[j].x + v[j].y * v[j].y) + (v[j].z * v[j].z + v[j].w * v[j].w); }
    const float rs = 1.f / sqrtf(wave_sum(s) * (1.f / DM) + EPS);
#pragma unroll
    for (int j = 0; j < 4; ++j) { const f32x4 ww = wr[64 * j]; o8[64 * j] = (unsigned long long)pk2(v[j].x * rs * ww.x, v[j].y * rs * ww.y) | ((unsigned long long)pk2(v[j].z * rs * ww.z, v[j].w * rs * ww.w) << 32); }
}

__device__ __forceinline__ void p0_prologue(const Frame& F, const Args& a) {
    LAS float* scr = (LAS float*)(F.lds + RING_OFF + F.wave * 16384);
    const int gw = F.vcu * NWAVES + F.wave, NGW = F.G * NWAVES;
    bf16* WTin = (bf16*)((unsigned char*)a.out + DO_WTIN); bf16* WTout = (bf16*)(a.ws + WS_WTOUT); bf16* WTup = (bf16*)(a.ws + WS_WTUP); bf16* WTdn = (bf16*)(a.ws + WS_WTDN);
    constexpr int I_IN = (LDP / 32) * (DM / 64), I_OUT = (DM / 32) * (2048 / 64), I_UP = (NUP / 32) * (DM / 64), I_DN = (DM / 32) * (DFF / 64);
    constexpr int NITEMS = I_IN + I_OUT + I_UP + I_DN;
    for (int it = gw; it < NITEMS; it += NGW) {
        int r = it;
        if (r < I_IN) { const int nb = r % (LDP / 32), kb = r / (LDP / 32); p0_transpose_item(a.in[IN_WIN], DM, NPROJ, NPROJ, WTin, nb * 32, nb * 32, kb * 64, nullptr, scr, F.lane); continue; } r -= I_IN;
        if (r < I_OUT) { const int nb = r % (DM / 32), kb = r / (DM / 32); p0_transpose_item(a.in[IN_WOUT], 2048, DM, DM, WTout, nb * 32, nb * 32, kb * 64, nullptr, scr, F.lane); continue; } r -= I_OUT;
        if (r < I_UP) { const int nb = r % (NUP / 32), kb = r / (NUP / 32); const int d0 = nb * 32, pn = d0 >> 8, rem = d0 & 255, bj = rem >> 7, j = rem & 127;
            p0_transpose_item(a.in[IN_WUP], DM, NUP, NUP, WTup, d0, bj * DFF + pn * 128 + j, kb * 64, a.in[IN_N2W], scr, F.lane); continue; } r -= I_UP;
        { const int nb = r % (DM / 32), kb = r / (DM / 32); p0_transpose_item(a.in[IN_WDN], DFF, DM, DM, WTdn, nb * 32, nb * 32, kb * 64, nullptr, scr, F.lane); }
    }
    bf16* U = (bf16*)((unsigned char*)a.out + DO_U);
    for (int m = gw; m < M1; m += NGW) {
        const float* src = (m < MREAL) ? a.in[IN_X] + (size_t)m * DM : (m < MROWS ? a.in[IN_META] + (size_t)(m - MREAL) * DM : nullptr);
        rms_row_to_bf16(F.lane, src, a.in[IN_N1W], U + (size_t)m * DM);
    }
}

__device__ __forceinline__ void p4_groupnorm(const Frame& F, const Args& a) {
    const int gw = F.vcu * NWAVES + F.wave, NGW = F.G * NWAVES;
    bf16* proj = (bf16*)(a.ws + WS_PROJ); bf16* mixmeta = (bf16*)(a.ws + WS_MIXMETA); const float* ssq = (const float*)(a.ws + WS_SSQ);
    for (int m = gw; m < MROWS; m += NGW) {
        bf16* p = (m < MREAL) ? proj + (size_t)m * LDP + Z0 : mixmeta + (size_t)(m - MREAL) * 2048 + 1024;
        const int g = F.lane >> 5; const f32x4* sp = (const f32x4*)(ssq + (size_t)m * 16 + g * 8); const f32x4 s0 = sp[0], s1 = sp[1];
        const float tot = ((s0[0] + s0[1]) + (s0[2] + s0[3])) + ((s1[0] + s1[1]) + (s1[2] + s1[3]));
        const float sc = 1.f / sqrtf(tot * (1.f / 512.f) + EPS);
        v4u* q = (v4u*)(p + F.lane * 16);
#pragma unroll
        for (int j = 0; j < 2; ++j) { v4u w = q[j]; v4u o;
            o.x = pk2(bflo(w.x) * sc, bfhi(w.x) * sc); o.y = pk2(bflo(w.y) * sc, bfhi(w.y) * sc); o.z = pk2(bflo(w.z) * sc, bfhi(w.z) * sc); o.w = pk2(bflo(w.w) * sc, bfhi(w.w) * sc); q[j] = o; }
    }
}
__device__ __forceinline__ float wave_dot_bf16(const bf16* x, const bf16* w, int n, int lane) {
    float s = 0.f;
    for (int i = lane * 8; i < n; i += 512) { const v4u a = *(const v4u*)(x + i), b = *(const v4u*)(w + i);
        s += bflo(a.x) * bflo(b.x) + bfhi(a.x) * bfhi(b.x) + bflo(a.y) * bflo(b.y) + bfhi(a.y) * bfhi(b.y) + bflo(a.z) * bflo(b.z) + bfhi(a.z) * bfhi(b.z) + bflo(a.w) * bflo(b.w) + bfhi(a.w) * bfhi(b.w); }
    return wave_sum(s);
}
__device__ __forceinline__ void p5_meta_tail(const Frame& F, const Args& a) {
    const int gw = F.vcu * NWAVES + F.wave, NGW = F.G * NWAVES;
    const bf16* mixmeta = (const bf16*)(a.ws + WS_MIXMETA); const bf16* WTout = (const bf16*)(a.ws + WS_WTOUT); float* h2m = (float*)(a.ws + WS_H2M);
    for (int o = gw; o < 2 * DM; o += NGW) { const int i = o / DM, n = o % DM;
        const float d = wave_dot_bf16(mixmeta + (size_t)(14 + i) * 2048, WTout + (size_t)n * 2048, 2048, F.lane);
        if (F.lane == 0) h2m[o] = a.in[IN_META][(size_t)(14 + i) * DM + n] + d; }
}
__device__ __forceinline__ void p6_meta_tail(const Frame& F, const Args& a) {
    const int gw = F.vcu * NWAVES + F.wave, NGW = F.G * NWAVES;
    const bf16* WTup = (const bf16*)(a.ws + WS_WTUP); const float* h2m = (const float*)(a.ws + WS_H2M); float* pmeta = (float*)(a.ws + WS_PMETA);
    for (int o = gw; o < 2 * NUP; o += NGW) { const int i = o / NUP, c = o % NUP; const int isv = c >= DFF, cc = isv ? c - DFF : c, n = (cc >> 7) * 256 + isv * 128 + (cc & 127);
        const float* h = h2m + (size_t)i * DM; const bf16* w = WTup + (size_t)n * DM; float s = 0.f, ss = 0.f;
        for (int k = F.lane * 8; k < DM; k += 512) { const f32x4 h0 = *(const f32x4*)(h + k), h1 = *(const f32x4*)(h + k + 4); const v4u b = *(const v4u*)(w + k);
            ss += (h0[0] * h0[0] + h0[1] * h0[1]) + (h0[2] * h0[2] + h0[3] * h0[3]) + (h1[0] * h1[0] + h1[1] * h1[1]) + (h1[2] * h1[2] + h1[3] * h1[3]);
            s += bf2f(f2bf(h0[0])) * bflo(b.x) + bf2f(f2bf(h0[1])) * bfhi(b.x) + bf2f(f2bf(h0[2])) * bflo(b.y) + bf2f(f2bf(h0[3])) * bfhi(b.y)
               + bf2f(f2bf(h1[0])) * bflo(b.z) + bf2f(f2bf(h1[1])) * bfhi(b.z) + bf2f(f2bf(h1[2])) * bflo(b.w) + bf2f(f2bf(h1[3])) * bfhi(b.w); }
        s = wave_sum(s); ss = wave_sum(ss);
        if (F.lane == 0) pmeta[o] = s / sqrtf(ss * (1.f / DM) + EPS); }
}
__device__ __forceinline__ void p7_conv_glu(const Frame& F, const Args& a) {
    bf16* proj = (bf16*)(a.ws + WS_PROJ); const bf16* halo = (const bf16*)(a.ws + WS_HALO); const float* pmeta = (const float*)(a.ws + WS_PMETA);
    const float* cw = a.in[IN_FCW]; const float* cb = a.in[IN_FCB];
    constexpr int CG = DFF / 8;
    const int NT = F.G * NWAVES * 64;
    for (int it = (F.vcu * NWAVES + F.wave) * 64 + F.lane; it < 256 * CG; it += NT) {
        const int rb = it / CG, c0 = (it % CG) * 8;
        const int vcol = (c0 < 1024) ? c0 : c0 + 3840;
        float wg[3][8], wv[3][8], bg[8], bv[8], g2[8], g1[8], v2[8], v1[8];
#pragma unroll
        for (int k = 0; k < 3; ++k)
#pragma unroll
            for (int j = 0; j < 8; ++j) { wg[k][j] = cw[k * NUP + c0 + j]; wv[k][j] = cw[k * NUP + DFF + c0 + j]; }
#pragma unroll
        for (int j = 0; j < 8; ++j) { bg[j] = cb[c0 + j]; bv[j] = cb[DFF + c0 + j]; }
        if ((rb & 63) == 0) {
#pragma unroll
            for (int j = 0; j < 8; ++j) { g2[j] = pmeta[c0 + j]; v2[j] = pmeta[DFF + c0 + j]; g1[j] = pmeta[NUP + c0 + j]; v1[j] = pmeta[NUP + DFF + c0 + j]; }
        } else {
            const bf16* h = halo + (size_t)((rb - 1) * 2) * NUP;
            const v4u a0 = *(const v4u*)(h + c0), a1 = *(const v4u*)(h + DFF + c0), b0 = *(const v4u*)(h + NUP + c0), b1 = *(const v4u*)(h + NUP + DFF + c0);
            g2[0] = bflo(a0.x); g2[1] = bfhi(a0.x); g2[2] = bflo(a0.y); g2[3] = bfhi(a0.y); g2[4] = bflo(a0.z); g2[5] = bfhi(a0.z); g2[6] = bflo(a0.w); g2[7] = bfhi(a0.w);
            v2[0] = bflo(a1.x); v2[1] = bfhi(a1.x); v2[2] = bflo(a1.y); v2[3] = bfhi(a1.y); v2[4] = bflo(a1.z); v2[5] = bfhi(a1.z); v2[6] = bflo(a1.w); v2[7] = bfhi(a1.w);
            g1[0] = bflo(b0.x); g1[1] = bfhi(b0.x); g1[2] = bflo(b0.y); g1[3] = bfhi(b0.y); g1[4] = bflo(b0.z); g1[5] = bfhi(b0.z); g1[6] = bflo(b0.w); g1[7] = bfhi(b0.w);
            v1[0] = bflo(b1.x); v1[1] = bfhi(b1.x); v1[2] = bflo(b1.y); v1[3] = bfhi(b1.y); v1[4] = bflo(b1.z); v1[5] = bfhi(b1.z); v1[6] = bflo(b1.w); v1[7] = bfhi(b1.w);
        }
        bf16* rowp = proj + (size_t)(rb * 64) * LDP;
#pragma unroll 2
        for (int r = 0; r < 64; ++r, rowp += LDP) {
            const v4u pg = *(const v4u*)(rowp + 2048 + c0), pv = *(const v4u*)(rowp + vcol);
            float g0[8], v0[8], o[8];
            g0[0] = bflo(pg.x); g0[1] = bfhi(pg.x); g0[2] = bflo(pg.y); g0[3] = bfhi(pg.y); g0[4] = bflo(pg.z); g0[5] = bfhi(pg.z); g0[6] = bflo(pg.w); g0[7] = bfhi(pg.w);
            v0[0] = bflo(pv.x); v0[1] = bfhi(pv.x); v0[2] = bflo(pv.y); v0[3] = bfhi(pv.y); v0[4] = bflo(pv.z); v0[5] = bfhi(pv.z); v0[6] = bflo(pv.w); v0[7] = bfhi(pv.w);
#pragma unroll
            for (int j = 0; j < 8; ++j) { const float ug = bg[j] + wg[0][j] * g2[j] + wg[1][j] * g1[j] + wg[2][j] * g0[j]; const float uv = bv[j] + wv[0][j] * v2[j] + wv[1][j] * v1[j] + wv[2][j] * v0[j];
                o[j] = siluf_(ug) * uv; g2[j] = g1[j]; g1[j] = g0[j]; v2[j] = v1[j]; v1[j] = v0[j]; }
            v4u w; w.x = pk2(o[0], o[1]); w.y = pk2(o[2], o[3]); w.z = pk2(o[4], o[5]); w.w = pk2(o[6], o[7]);
            *(v4u*)(rowp + 2048 + c0) = w;
        }
    }
}
__device__ __forceinline__ void p9_final_norm(const Frame& F, const Args& a) {
    const int gw = F.vcu * NWAVES + F.wave, NGW = F.G * NWAVES;
    const float* rss = (const float*)(a.ws + WS_SSQ); const f32x4* wv = (const f32x4*)a.in[IN_FNW] + F.lane;
    for (int m = gw; m < MREAL; m += NGW) {
        const f32x4* rp = (const f32x4*)(rss + (size_t)m * 16); const f32x4 sa = rp[0], sb = rp[1], sc_ = rp[2], sd = rp[3];
        const float tot = (((sa[0] + sa[1]) + (sa[2] + sa[3])) + ((sb[0] + sb[1]) + (sb[2] + sb[3]))) + (((sc_[0] + sc_[1]) + (sc_[2] + sc_[3])) + ((sd[0] + sd[1]) + (sd[2] + sd[3])));
        const float rs = 1.f / sqrtf(tot * (1.f / DM) + EPS);
        f32x4* o = (f32x4*)(a.out + (size_t)m * DM) + F.lane;
#pragma unroll
        for (int j = 0; j < 4; ++j) { const f32x4 v = o[64 * j], w = wv[64 * j]; o[64 * j] = v * rs * w; }
    }
}

__device__ __forceinline__ size_t pos_row(int b, int pos) { return pos < NMETA ? (size_t)(MREAL + pos) : (size_t)b * SEQ + (pos - NMETA); }

__device__ __forceinline__ void slow_hgrn2_body(const Args& a, LAS float* sm, int blk, int tid) {
    const int b = blk >> 3, h = blk & 7, v = tid & 127; const bool act = tid < 128;
    LAS float* sq = sm; LAS float* sf = sm + 128; LAS float* sk = sm + 256; LAS float* red = sm + 384;
    bf16* proj = (bf16*)(a.ws + WS_PROJ); bf16* mixmeta = (bf16*)(a.ws + WS_MIXMETA);
    const float l0 = a.in[IN_LBL][h * 128 + v], l1 = a.in[IN_LBL][1024 + h * 128 + v];
    const float lb = 1.f / (1.f + expf(l1 - l0));
    const float nw = a.in[IN_HGNW][h * 128 + v];
    float s[128];
#pragma unroll
    for (int k = 0; k < 128; ++k) s[k] = 0.f;
    for (int pos = 0; pos < NMETA + SEQ; ++pos) {
        bf16* pr = proj + pos_row(b, pos) * LDP + h * 128 + v;
        const float qp = bf2f(pr[Q0]), fp = bf2f(pr[F0]), iv = bf2f(pr[I0]), gv = bf2f(pr[G0]);
        const float f = lb + (1.f - lb) * sigmoidf_(fp);
        if (act) { sq[v] = siluf_(qp); sf[v] = f; sk[v] = 1.f - f; }
        __syncthreads();
        float o = 0.f;
#pragma unroll
        for (int k = 0; k < 128; ++k) { s[k] = sf[k] * s[k] + sk[k] * iv; o += sq[k] * s[k]; }
        const float ss = wave_sum(o * o);
        if (act && (v & 63) == 0) red[v >> 6] = ss;
        __syncthreads();
        const float tot = red[0] + red[1];
        const float on = o / sqrtf(tot * (1.f / 128.f) + EPS) * nw * siluf_(gv);
        if (!act) continue;
        if (pos >= NMETA) pr[Q0] = (bf16)f2bf(on);
        else if (b == 0) mixmeta[(size_t)pos * 2048 + h * 128 + v] = (bf16)f2bf(on);
    }
}

__device__ __forceinline__ void slow_mamba_body(const Args& a, LAS float* sm, int blk, int tid) {
    const int b = blk >> 4, hm = blk & 15, g = hm >> 3, p = tid & 63; const bool act = tid < 64;
    LAS float* sB = sm; LAS float* sC = sm + 128;
    bf16* proj = (bf16*)(a.ws + WS_PROJ); bf16* mixmeta = (bf16*)(a.ws + WS_MIXMETA); float* ssq = (float*)(a.ws + WS_SSQ);
    const float* cw = a.in[IN_CW]; const float* cb = a.in[IN_CB];
    const float A = -expf(a.in[IN_ALOG][hm]), Dh = a.in[IN_D][hm], dtb = a.in[IN_DTB][hm], nw = a.in[IN_M2NW][hm * 64 + p];
    float s[128];
#pragma unroll
    for (int n = 0; n < 128; ++n) s[n] = 0.f;
    const int ch[5] = { hm * 64 + p, 1024 + g * 128 + p, 1024 + g * 128 + 64 + p, 1280 + g * 128 + p, 1280 + g * 128 + 64 + p };
    for (int pos = 0; pos < NMETA + SEQ; ++pos) {
        float cv[5];
#pragma unroll
        for (int c = 0; c < 5; ++c) { float acc = cb[ch[c]];
#pragma unroll
            for (int k = 0; k < 4; ++k) { const int pp = pos - 3 + k; if (pp >= 0) acc += cw[k * 1536 + ch[c]] * bf2f(proj[pos_row(b, pp) * LDP + XBC0 + ch[c]]); }
            cv[c] = siluf_(acc); }
        const size_t row = pos_row(b, pos);
        const float dt = softplusf_(bf2f(proj[row * LDP + DT0 + hm]) + dtb), dec = expf(dt * A);
        const float xv = cv[0], xdt = xv * dt;
        if (act) { sB[p] = cv[1]; sB[p + 64] = cv[2]; sC[p] = cv[3]; sC[p + 64] = cv[4]; }
        __syncthreads();
        float y = 0.f;
#pragma unroll
        for (int n = 0; n < 128; ++n) { s[n] = dec * s[n] + sB[n] * xdt; y += sC[n] * s[n]; }
        y += Dh * xv;
        bf16* zp = proj + row * LDP + Z0 + hm * 64 + p;
        y *= siluf_(bf2f(*zp));
        const float ss = wave_sum(y * y);
        if (act) {
        if (pos >= NMETA || b == 0) { if (p == 0) ssq[row * 16 + hm] = ss; }
        if (pos >= NMETA) *zp = (bf16)f2bf(y * nw);
        else if (b == 0) mixmeta[(size_t)pos * 2048 + 1024 + hm * 64 + p] = (bf16)f2bf(y * nw);
        }
        __syncthreads();
    }
}


namespace mix {
constexpr int QP = 136, TP = 72;
constexpr int L_QD = 0, L_KI = 17408, L_KET = 34816, L_VT = 53248, L_VET = 71680, L_XT = 90112, L_SC = 108544, L_SM = 126976;
constexpr size_t DO_HGU = 0, DO_MBU = 16 * MiB, DO_HGD = 32 * MiB, DO_MBD = 33 * MiB;
typedef unsigned long long u64;
typedef float f32x2 __attribute__((ext_vector_type(2)));
typedef short bf16x4 __attribute__((ext_vector_type(4)));
#define MFMA16(a, b, c) __builtin_amdgcn_mfma_f32_16x16x32_bf16((a), (b), (c), 0, 0, 0)

__device__ __forceinline__ size_t seq_row(int b, int p) { return p < NMETA ? (size_t)(MREAL + p) : (size_t)b * SEQ + (p - NMETA); }
__device__ __forceinline__ unsigned row_off(int b, int p) { return (unsigned)(p < NMETA ? (MREAL + p) : b * SEQ + (p - NMETA)) * (unsigned)(LDP * 2); }
__device__ __forceinline__ float ldbf(const unsigned char* base, unsigned off) { return bf2f(*(const bf16*)(base + off)); }
__device__ __forceinline__ v4u pack8f(const float* x) { v4u w; w.x = pk2(x[0], x[1]); w.y = pk2(x[2], x[3]); w.z = pk2(x[4], x[5]); w.w = pk2(x[6], x[7]); return w; }
__device__ __forceinline__ bf16x8 ld_frag16(const LAS unsigned char* p) { return *(const LAS bf16x8*)p; }
__device__ __forceinline__ bf16x8 ld_frag8x2(const LAS unsigned char* p0, const LAS unsigned char* p1) {
    const bf16x4 a = *(const LAS bf16x4*)p0, b = *(const LAS bf16x4*)p1; return __builtin_shufflevector(a, b, 0, 1, 2, 3, 4, 5, 6, 7); }
__device__ __forceinline__ bf16x8 pack_state(const f32x4 a, const f32x4 b) {
    v4u w; w.x = pk2(a[0], a[1]); w.y = pk2(a[2], a[3]); w.z = pk2(b[0], b[1]); w.w = pk2(b[2], b[3]); return __builtin_bit_cast(bf16x8, w); }

template <bool OUT>
__device__ __forceinline__ void hgrn2_item(LAS unsigned char* L, const Args& a, int bh, int j, int tid, int wave, int lane) {
    const int b = bh >> 3, h = bh & 7;
    const int k = tid & 127, seg = tid >> 7, n = lane & 15, g = lane >> 4;
    bf16* proj = (bf16*)(a.ws + WS_PROJ); bf16* mixmeta = (bf16*)(a.ws + WS_MIXMETA); const unsigned char* pb = a.ws + WS_PROJ;
    float* HGU = (float*)((unsigned char*)a.out + DO_HGU); float* HGD = (float*)((unsigned char*)a.out + DO_HGD);
    LAS float* segtot = (LAS float*)(L + L_SM); LAS float* dvec = (LAS float*)(L + L_SM + 2048); LAS float* emid = (LAS float*)(L + L_SM + 2560);
    LAS float* red = (LAS float*)(L + L_VET); LAS float* rinv = (LAS float*)(L + L_VET + 2048);
    const float lb = 1.f / (1.f + __expf(a.in[IN_LBL][1024 + h * 128 + k] - a.in[IN_LBL][h * 128 + k]));
    const float nw = OUT ? a.in[IN_HGNW][h * 128 + wave * 16 + n] : 0.f;
    f32x4 S[8];
#pragma unroll
    for (int kt = 0; kt < 8; ++kt) S[kt] = (f32x4){0.f, 0.f, 0.f, 0.f};
    if (OUT) {
        for (int i = 0; i < j; ++i) { const float* U = HGU + ((size_t)(bh * 7 + i)) * 16384 + (size_t)(wave * 8 * 64 + lane) * 4; const float* D = HGD + (size_t)(bh * 7 + i) * 128 + 4 * g;
#pragma unroll
            for (int kt = 0; kt < 8; ++kt) { const f32x4 d4 = *(const f32x4*)(D + kt * 16), u4 = *(const f32x4*)(U + kt * 256); S[kt] = S[kt] * d4 + u4; } }
    }
    float bsum = 0.f;
    const int c0 = j == 0 ? 0 : 8 * j + 1, c1 = 8 * j + 8;
    for (int c = c0; c <= c1; ++c) {
        const int p0 = c * 64 + seg * 16 - 48;
        float lf[16], kk[16], qv[16], vv[16];
#pragma unroll
        for (int i = 0; i < 16; ++i) { const int p = p0 + i;
            if (p >= 0) { const unsigned ro = row_off(b, p) + (unsigned)(h * 128 + k) * 2u; const float fp = ldbf(pb, ro + F0 * 2); vv[i] = ldbf(pb, ro + I0 * 2); qv[i] = OUT ? ldbf(pb, ro + Q0 * 2) : 0.f;
                const float f = lb + (1.f - lb) * sigmoidf_(fp); lf[i] = __logf(f); kk[i] = 1.f - f; }
            else { lf[i] = 0.f; kk[i] = 0.f; qv[i] = 0.f; vv[i] = 0.f; } }
        float run = 0.f;
#pragma unroll
        for (int i = 0; i < 16; ++i) { run += lf[i]; lf[i] = run; }
        segtot[seg * 128 + k] = run;
        __syncthreads();
        const float t0 = segtot[k], t1 = segtot[128 + k], t2 = segtot[256 + k], t3 = segtot[384 + k];
        const float off = seg == 0 ? 0.f : (seg == 1 ? t0 : (seg == 2 ? t0 + t1 : (t0 + t1) + t2));
        const float bmid = t0 + t1, blast = (t0 + t1) + (t2 + t3);
        float ke[16];
#pragma unroll
        for (int i = 0; i < 16; ++i) { const float bc = off + lf[i];
            if (OUT) { ((LAS bf16*)(L + L_QD))[(16 * seg + i) * QP + k] = (bf16)f2bf(siluf_(qv[i]) * __expf(bc - bmid)); ((LAS bf16*)(L + L_KI))[(16 * seg + i) * QP + k] = (bf16)f2bf(kk[i] * __expf(bmid - bc)); }
            ke[i] = kk[i] * __expf(blast - bc); }
        *(LAS v4u*)(L + L_KET + (k * TP + 16 * seg) * 2) = pack8f(ke); *(LAS v4u*)(L + L_KET + (k * TP + 16 * seg + 8) * 2) = pack8f(ke + 8);
        *(LAS v4u*)(L + L_VT + (k * TP + 16 * seg) * 2) = pack8f(vv); *(LAS v4u*)(L + L_VT + (k * TP + 16 * seg + 8) * 2) = pack8f(vv + 8);
        if (seg == 0) { dvec[k] = __expf(blast); emid[k] = __expf(bmid); bsum += blast; }
        __syncthreads();
        float gv[4][4];
        if (OUT) {
#pragma unroll
            for (int tt = 0; tt < 4; ++tt)
#pragma unroll
                for (int r = 0; r < 4; ++r) { const int p = c * 64 + tt * 16 + 4 * g + r - 48; gv[tt][r] = p >= 0 ? ldbf(pb, row_off(b, p) + (unsigned)(G0 + h * 128 + wave * 16 + n) * 2u) : 0.f; }
        }
        bf16x8 vf[2];
#pragma unroll
        for (int ss = 0; ss < 2; ++ss) vf[ss] = ld_frag16(L + L_VT + ((wave * 16 + n) * TP + ss * 32 + 8 * g) * 2);
        f32x4 O[4];
        if (OUT) {
            const int ti = wave >> 1;
#pragma unroll
            for (int q = 0; q < 2; ++q) { const int si = 2 * (wave & 1) + q; f32x4 acc = (f32x4){0.f, 0.f, 0.f, 0.f};
                if (si <= ti) {
#pragma unroll
                    for (int ks = 0; ks < 4; ++ks) acc = MFMA16(ld_frag16(L + L_QD + ((ti * 16 + n) * QP + ks * 32 + 8 * g) * 2), ld_frag16(L + L_KI + ((si * 16 + n) * QP + ks * 32 + 8 * g) * 2), acc); }
#pragma unroll
                for (int r = 0; r < 4; ++r) { const int t = ti * 16 + 4 * g + r, s_ = si * 16 + n; ((LAS bf16*)(L + L_SC))[t * TP + s_] = (bf16)f2bf(t >= s_ ? acc[r] : 0.f); } }
            __syncthreads();
#pragma unroll
            for (int tt = 0; tt < 4; ++tt) { O[tt] = (f32x4){0.f, 0.f, 0.f, 0.f};
#pragma unroll
                for (int ss = 0; ss < 2; ++ss) if (ss * 32 <= tt * 16 + 15) O[tt] = MFMA16(ld_frag16(L + L_SC + ((tt * 16 + n) * TP + ss * 32 + 8 * g) * 2), vf[ss], O[tt]); }
            bf16x8 sb[4];
#pragma unroll
            for (int ks = 0; ks < 4; ++ks) { const f32x4 e0 = *(const LAS f32x4*)(emid + (2 * ks) * 16 + 4 * g), e1 = *(const LAS f32x4*)(emid + (2 * ks + 1) * 16 + 4 * g); sb[ks] = pack_state(S[2 * ks] * e0, S[2 * ks + 1] * e1); }
#pragma unroll
            for (int tt = 0; tt < 4; ++tt)
#pragma unroll
                for (int ks = 0; ks < 4; ++ks) { const LAS unsigned char* qp = L + L_QD + ((tt * 16 + n) * QP + ks * 32 + 4 * g) * 2; O[tt] = MFMA16(ld_frag8x2(qp, qp + 32), sb[ks], O[tt]); }
        }
#pragma unroll
        for (int kt = 0; kt < 8; ++kt) { const f32x4 d4 = *(const LAS f32x4*)(dvec + kt * 16 + 4 * g); S[kt] = S[kt] * d4;
#pragma unroll
            for (int ts = 0; ts < 2; ++ts) S[kt] = MFMA16(ld_frag16(L + L_KET + ((kt * 16 + n) * TP + ts * 32 + 8 * g) * 2), vf[ts], S[kt]); }
        if (OUT) {
#pragma unroll
            for (int tt = 0; tt < 4; ++tt)
#pragma unroll
                for (int r = 0; r < 4; ++r) { float ss = O[tt][r] * O[tt][r]; ss += __shfl_xor(ss, 1); ss += __shfl_xor(ss, 2); ss += __shfl_xor(ss, 4); ss += __shfl_xor(ss, 8); if (n == 0) red[wave * 64 + tt * 16 + 4 * g + r] = ss; }
            __syncthreads();
            if (tid < 64) { float tot = 0.f;
#pragma unroll
                for (int w = 0; w < 8; ++w) tot += red[w * 64 + tid];
                rinv[tid] = 1.f / sqrtf(tot * (1.f / 128.f) + EPS); }
            __syncthreads();
#pragma unroll
            for (int tt = 0; tt < 4; ++tt) { const f32x4 ri = *(const LAS f32x4*)(rinv + tt * 16 + 4 * g);
#pragma unroll
                for (int r = 0; r < 4; ++r) { const int p = c * 64 + tt * 16 + 4 * g + r - 48; const bf16 o = (bf16)f2bf(O[tt][r] * ri[r] * nw * siluf_(gv[tt][r]));
                    if (p >= NMETA) proj[seq_row(b, p) * LDP + Q0 + h * 128 + wave * 16 + n] = o;
                    else if (p >= 0 && b == 0) mixmeta[(size_t)p * 2048 + h * 128 + wave * 16 + n] = o; } }
        } else {
            __syncthreads();
        }
    }
    if (!OUT) {
        float* U = HGU + ((size_t)(bh * 7 + j)) * 16384 + (size_t)(wave * 8 * 64 + lane) * 4;
#pragma unroll
        for (int kt = 0; kt < 8; ++kt) *(f32x4*)(U + kt * 256) = S[kt];
        if (seg == 0) HGD[(size_t)(bh * 7 + j) * 128 + k] = __expf(bsum);
    }
}

template <bool OUT>
__device__ __forceinline__ void mamba_item(LAS unsigned char* L, const Args& a, int bp, int j, int tid, int wave, int lane) {
    const int b = bp >> 3, pair = bp & 7, grp = pair >> 2, hm0 = 2 * pair;
    const int c_ = tid & 127, seg = tid >> 7, hd = c_ >> 6, n = lane & 15, g = lane >> 4, whd = wave >> 2;
    bf16* proj = (bf16*)(a.ws + WS_PROJ); bf16* mixmeta = (bf16*)(a.ws + WS_MIXMETA); float* ssq = (float*)(a.ws + WS_SSQ); const unsigned char* pb = a.ws + WS_PROJ;
    float* MBU = (float*)((unsigned char*)a.out + DO_MBU); float* MBD = (float*)((unsigned char*)a.out + DO_MBD);
    LAS float* acum = (LAS float*)(L + L_SM); LAS float* eac = (LAS float*)(L + L_SM + 512); LAS float* misc = (LAS float*)(L + L_SM + 1024);
    LAS float* red = (LAS float*)(L + L_SM + 2048);
    const float* cw = a.in[IN_CW]; const float* cb = a.in[IN_CB];
    const int colx = hm0 * 64 + c_, colb = 1024 + grp * 128 + c_, colc = 1280 + grp * 128 + c_;
    const float Ah = -__expf(a.in[IN_ALOG][hm0 + hd]), dtb = a.in[IN_DTB][hm0 + hd];
    const float Dw = OUT ? a.in[IN_D][hm0 + whd] : 0.f, nw = OUT ? a.in[IN_M2NW][hm0 * 64 + wave * 16 + n] : 0.f;
    f32x4 S[8];
#pragma unroll
    for (int kt = 0; kt < 8; ++kt) S[kt] = (f32x4){0.f, 0.f, 0.f, 0.f};
    if (OUT) {
        for (int i = 0; i < j; ++i) { const float* U = MBU + ((size_t)(bp * 7 + i)) * 16384 + (size_t)(wave * 8 * 64 + lane) * 4; const float d = MBD[(size_t)(bp * 7 + i) * 2 + whd];
#pragma unroll
            for (int kt = 0; kt < 8; ++kt) { const f32x4 u4 = *(const f32x4*)(U + kt * 256); S[kt] = S[kt] * d + u4; } }
    }
    float asum = 0.f;
    const int c0 = j == 0 ? 0 : 8 * j + 1, c1 = 8 * j + 8;
    for (int c = c0; c <= c1; ++c) {
        const int p0 = c * 64 + seg * 16 - 48;
#define MB_RO(i) (row_off(b, p0 - 3 + (i)) + XBC0 * 2)
#define MB_OK(i) (p0 - 3 + (i) >= 0)
        {
            float rb[19], Bs[16]; float wb[4];
#pragma unroll
            for (int q = 0; q < 4; ++q) wb[q] = cw[q * 1536 + colb];
            const float bb = cb[colb];
#pragma unroll
            for (int i = 0; i < 19; ++i) rb[i] = MB_OK(i) ? ldbf(pb, MB_RO(i) + (unsigned)colb * 2u) : 0.f;
#pragma unroll
            for (int i = 0; i < 16; ++i) { Bs[i] = siluf_(bb + wb[0] * rb[i] + wb[1] * rb[i + 1] + wb[2] * rb[i + 2] + wb[3] * rb[i + 3]);
                if (OUT) ((LAS bf16*)(L + L_KI))[(16 * seg + i) * QP + c_] = (bf16)f2bf(Bs[i]); }
            *(LAS v4u*)(L + L_KET + (c_ * TP + 16 * seg) * 2) = pack8f(Bs); *(LAS v4u*)(L + L_KET + (c_ * TP + 16 * seg + 8) * 2) = pack8f(Bs + 8);
        }
        if (OUT) {
            float rc[19]; float wc[4];
#pragma unroll
            for (int q = 0; q < 4; ++q) wc[q] = cw[q * 1536 + colc];
            const float bc_ = cb[colc];
#pragma unroll
            for (int i = 0; i < 19; ++i) rc[i] = MB_OK(i) ? ldbf(pb, MB_RO(i) + (unsigned)colc * 2u) : 0.f;
#pragma unroll
            for (int i = 0; i < 16; ++i) ((LAS bf16*)(L + L_QD))[(16 * seg + i) * QP + c_] = (bf16)f2bf(siluf_(bc_ + wc[0] * rc[i] + wc[1] * rc[i + 1] + wc[2] * rc[i + 2] + wc[3] * rc[i + 3]));
        }
        float vv[16], pre[16];
        float run = 0.f;
        {
            float rx[19], xs[16]; float wx[4];
#pragma unroll
            for (int q = 0; q < 4; ++q) wx[q] = cw[q * 1536 + colx];
            const float bx = cb[colx];
#pragma unroll
            for (int i = 0; i < 19; ++i) rx[i] = MB_OK(i) ? ldbf(pb, MB_RO(i) + (unsigned)colx * 2u) : 0.f;
#pragma unroll
            for (int i = 0; i < 16; ++i) { const float dt = MB_OK(i + 3) ? softplusf_(ldbf(pb, MB_RO(i + 3) + (unsigned)(DT0 - XBC0 + hm0 + hd) * 2u) + dtb) : 0.f;
                xs[i] = siluf_(bx + wx[0] * rx[i] + wx[1] * rx[i + 1] + wx[2] * rx[i + 2] + wx[3] * rx[i + 3]);
                vv[i] = xs[i] * dt; run += dt * Ah; pre[i] = run; }
            if (OUT) { *(LAS v4u*)(L + L_XT + (c_ * TP + 16 * seg) * 2) = pack8f(xs); *(LAS v4u*)(L + L_XT + (c_ * TP + 16 * seg + 8) * 2) = pack8f(xs + 8);
                *(LAS v4u*)(L + L_VT + (c_ * TP + 16 * seg) * 2) = pack8f(vv); *(LAS v4u*)(L + L_VT + (c_ * TP + 16 * seg + 8) * 2) = pack8f(vv + 8); }
        }
#undef MB_RO
#undef MB_OK
        if ((c_ & 63) == 0) misc[8 + 4 * hd + seg] = run;
        __syncthreads();
        const float t0 = misc[8 + 4 * hd], t1 = misc[9 + 4 * hd], t2 = misc[10 + 4 * hd], t3 = misc[11 + 4 * hd];
        const float off = seg == 0 ? 0.f : (seg == 1 ? t0 : (seg == 2 ? t0 + t1 : (t0 + t1) + t2));
        const float alast = (t0 + t1) + (t2 + t3);
        float ve[16];
#pragma unroll
        for (int i = 0; i < 16; ++i) { const float ac = off + pre[i]; ve[i] = vv[i] * __expf(alast - ac);
            if (OUT) { if ((c_ & 63) == 0) { acum[hd * 64 + 16 * seg + i] = ac; eac[hd * 64 + 16 * seg + i] = __expf(ac); } } }
        *(LAS v4u*)(L + L_VET + (c_ * TP + 16 * seg) * 2) = pack8f(ve); *(LAS v4u*)(L + L_VET + (c_ * TP + 16 * seg + 8) * 2) = pack8f(ve + 8);
        if ((c_ & 63) == 0 && seg == 0) { misc[hd] = __expf(alast); asum += alast; }
        __syncthreads();
        float zv[4][4];
        if (OUT) {
#pragma unroll
            for (int tt = 0; tt < 4; ++tt)
#pragma unroll
                for (int r = 0; r < 4; ++r) { const int p = c * 64 + tt * 16 + 4 * g + r - 48; zv[tt][r] = p >= 0 ? ldbf(pb, row_off(b, p) + (unsigned)(Z0 + hm0 * 64 + wave * 16 + n) * 2u) : 0.f; }
        }
        bf16x8 vef[2];
#pragma unroll
        for (int ss = 0; ss < 2; ++ss) vef[ss] = ld_frag16(L + L_VET + ((wave * 16 + n) * TP + ss * 32 + 8 * g) * 2);
        f32x4 O[4];
        if (OUT) {
            const int ti = wave >> 1;
#pragma unroll
            for (int q = 0; q < 2; ++q) { const int si = 2 * (wave & 1) + q; f32x4 acc = (f32x4){0.f, 0.f, 0.f, 0.f};
                if (si <= ti) {
#pragma unroll
                    for (int ks = 0; ks < 4; ++ks) acc = MFMA16(ld_frag16(L + L_QD + ((ti * 16 + n) * QP + ks * 32 + 8 * g) * 2), ld_frag16(L + L_KI + ((si * 16 + n) * QP + ks * 32 + 8 * g) * 2), acc); }
#pragma unroll
                for (int h2 = 0; h2 < 2; ++h2) { const f32x4 at = *(const LAS f32x4*)(acum + h2 * 64 + ti * 16 + 4 * g); const float as = acum[h2 * 64 + si * 16 + n];
#pragma unroll
                    for (int r = 0; r < 4; ++r) { const int t = ti * 16 + 4 * g + r, s_ = si * 16 + n; ((LAS bf16*)(L + L_SC))[(h2 * 64 + t) * TP + s_] = (bf16)f2bf(t >= s_ ? acc[r] * __expf(at[r] - as) : 0.f); } } }
            __syncthreads();
            bf16x8 vf[2];
#pragma unroll
            for (int ss = 0; ss < 2; ++ss) vf[ss] = ld_frag16(L + L_VT + ((wave * 16 + n) * TP + ss * 32 + 8 * g) * 2);
            f32x4 O2[4];
#pragma unroll
            for (int tt = 0; tt < 4; ++tt) { O[tt] = (f32x4){0.f, 0.f, 0.f, 0.f}; O2[tt] = (f32x4){0.f, 0.f, 0.f, 0.f};
#pragma unroll
                for (int ss = 0; ss < 2; ++ss) if (ss * 32 <= tt * 16 + 15) O[tt] = MFMA16(ld_frag16(L + L_SC + ((whd * 64 + tt * 16 + n) * TP + ss * 32 + 8 * g) * 2), vf[ss], O[tt]); }
            bf16x8 sb[4];
#pragma unroll
            for (int ks = 0; ks < 4; ++ks) sb[ks] = pack_state(S[2 * ks], S[2 * ks + 1]);
#pragma unroll
            for (int tt = 0; tt < 4; ++tt)
#pragma unroll
                for (int ks = 0; ks < 4; ++ks) { const LAS unsigned char* qp = L + L_QD + ((tt * 16 + n) * QP + ks * 32 + 4 * g) * 2; O2[tt] = MFMA16(ld_frag8x2(qp, qp + 32), sb[ks], O2[tt]); }
#pragma unroll
            for (int tt = 0; tt < 4; ++tt) { const f32x4 ea = *(const LAS f32x4*)(eac + whd * 64 + tt * 16 + 4 * g); O[tt] = O[tt] + ea * O2[tt]; }
        }
        { const float el = misc[whd];
#pragma unroll
          for (int kt = 0; kt < 8; ++kt) { S[kt] = S[kt] * el;
#pragma unroll
            for (int ts = 0; ts < 2; ++ts) S[kt] = MFMA16(ld_frag16(L + L_KET + ((kt * 16 + n) * TP + ts * 32 + 8 * g) * 2), vef[ts], S[kt]); } }
        if (OUT) {
            float y[4][4];
#pragma unroll
            for (int tt = 0; tt < 4; ++tt) { const v4u xq = (v4u){0u, 0u, 0u, 0u}; (void)xq;
                const u64 xw = *(const LAS u64*)(L + L_XT + ((wave * 16 + n) * TP + tt * 16 + 4 * g) * 2);
                const float x0 = bflo((unsigned)xw), x1 = bfhi((unsigned)xw), x2 = bflo((unsigned)(xw >> 32)), x3 = bfhi((unsigned)(xw >> 32));
                y[tt][0] = (O[tt][0] + Dw * x0) * siluf_(zv[tt][0]); y[tt][1] = (O[tt][1] + Dw * x1) * siluf_(zv[tt][1]);
                y[tt][2] = (O[tt][2] + Dw * x2) * siluf_(zv[tt][2]); y[tt][3] = (O[tt][3] + Dw * x3) * siluf_(zv[tt][3]);
#pragma unroll
                for (int r = 0; r < 4; ++r) { float ss = y[tt][r] * y[tt][r]; ss += __shfl_xor(ss, 1); ss += __shfl_xor(ss, 2); ss += __shfl_xor(ss, 4); ss += __shfl_xor(ss, 8); if (n == 0) red[wave * 64 + tt * 16 + 4 * g + r] = ss; } }
            __syncthreads();
            if (tid < 128) { const int h2 = tid >> 6, t = tid & 63; const float tot = (red[(4 * h2) * 64 + t] + red[(4 * h2 + 1) * 64 + t]) + (red[(4 * h2 + 2) * 64 + t] + red[(4 * h2 + 3) * 64 + t]);
                const int p = c * 64 + t - 48; if (p >= NMETA || (p >= 0 && b == 0)) ssq[seq_row(b, p) * 16 + hm0 + h2] = tot; }
#pragma unroll
            for (int tt = 0; tt < 4; ++tt)
#pragma unroll
                for (int r = 0; r < 4; ++r) { const int p = c * 64 + tt * 16 + 4 * g + r - 48; const bf16 o = (bf16)f2bf(y[tt][r] * nw);
                    if (p >= NMETA) proj[seq_row(b, p) * LDP + Z0 + hm0 * 64 + wave * 16 + n] = o;
                    else if (p >= 0 && b == 0) mixmeta[(size_t)p * 2048 + 1024 + hm0 * 64 + wave * 16 + n] = o; }
        } else {
            __syncthreads();
        }
    }
    if (!OUT) {
        float* U = MBU + ((size_t)(bp * 7 + j)) * 16384 + (size_t)(wave * 8 * 64 + lane) * 4;
#pragma unroll
        for (int kt = 0; kt < 8; ++kt) *(f32x4*)(U + kt * 256) = S[kt];
        if ((c_ & 63) == 0 && seg == 0) MBD[(size_t)(bp * 7 + j) * 2 + hd] = __expf(asum);
    }
}
#undef MFMA16
}
__global__ void __launch_bounds__(NWAVES * 64, 2) mk_fwd(Args args) {
    extern __shared__ __attribute__((aligned(16))) unsigned char lds[];
    Frame F;
    F.lds = (LAS unsigned char*)lds;
    F.tid = threadIdx.x; F.lane = F.tid & 63; F.wave = __builtin_amdgcn_readfirstlane(F.tid >> 6);
    F.G = gridDim.x; { const int bx = blockIdx.x; F.vcu = (F.G % 8 == 0) ? (bx % 8) * (F.G / 8) + bx / 8 : bx; }
    volatile LAS unsigned* MISC = (volatile LAS unsigned*)(F.lds + MISC_OFF);
    unsigned char* ws = args.ws;
    for (int u = F.tid; u < (LDS_BYTES - LDSCTL_OFF) / 4; u += NWAVES * 64) ((LAS unsigned*)(F.lds + LDSCTL_OFF))[u] = 0u;
    __syncthreads();
    const int lo = args.ph_lo, hi = args.ph_hi;
    const bool use_bar = (hi - lo) > 1;
    XcdBarrier bar; bar.bar = (unsigned*)(ws + WS_CTL) + CW_BAR; bar.x = 0; bar.st = nullptr;
    if (use_bar) bar = xcd_barrier_post((unsigned*)(ws + WS_CTL) + CW_BAR, MISC + 8);
#define IN(k) (lo <= (k) && (k) < hi)
#define SEAM(k) do { if (IN(k) && IN((k) + 1)) xcd_barrier(bar); } while (0)
    bf16* proj = (bf16*)(ws + WS_PROJ);

    if (IN(0)) { p0_prologue(F, args); SEAM(0); }
    if (IN(1)) {
        pg8::Gemm g{(const bf16*)((unsigned char*)args.out + DO_U), (const bf16*)((unsigned char*)args.out + DO_WTIN), M1, LDP, DM, DM, 1 << 30, 0};
        pg8::StaticOrder S; S.init(M1, LDP, F.G, (int)blockIdx.x);
        pg8::EpiBf16 E{proj, LDP};
        pg8::gemm_phase<pg8::EpiBf16, pg8::StaticOrder, true, true>(F.lds + RING_OFF, g, S, E);
        SEAM(1);
    }
    if (IN(2)) {
#if MK_SLOW_HG
        if (blockIdx.x < 32) slow_hgrn2_body(args, (LAS float*)(F.lds + RING_OFF), (int)blockIdx.x, F.tid);
#endif
#if MK_SLOW_MB
        if (blockIdx.x >= 32 && blockIdx.x < 96) slow_mamba_body(args, (LAS float*)(F.lds + RING_OFF), (int)blockIdx.x - 32, F.tid);
#endif
        for (int it = F.vcu; it < 448; it += F.G) {
            if (it < 224) { if (!MK_SLOW_HG) mix::hgrn2_item<false>(F.lds + RING_OFF, args, it / 7, it % 7, F.tid, F.wave, F.lane); }
            else { if (!MK_SLOW_MB) mix::mamba_item<false>(F.lds + RING_OFF, args, (it - 224) / 7, (it - 224) % 7, F.tid, F.wave, F.lane); }
        }
        SEAM(2);
    }
    if (IN(3)) {
        if (!MK_SLOW_HG) for (int it = F.vcu; it < 256; it += F.G) { mix::hgrn2_item<true>(F.lds + RING_OFF, args, it >> 3, it & 7, F.tid, F.wave, F.lane); __syncthreads(); }
        if (!MK_SLOW_MB) for (int it = F.vcu; it < 256; it += F.G) { mix::mamba_item<true>(F.lds + RING_OFF, args, it >> 3, 7 - (it & 7), F.tid, F.wave, F.lane); __syncthreads(); }
        SEAM(3);
    }
    if (IN(4)) { p4_groupnorm(F, args); SEAM(4); }
    if (IN(5)) {
        p5_meta_tail(F, args); VM_WAIT(); __syncthreads();
        pg8::Gemm g{proj, (const bf16*)(ws + WS_WTOUT), MREAL, DM, 2048, LDP, 16, (Z0 - 1024) * 2};
        pg8::StaticOrder S; S.init(MREAL, DM, F.G, (int)blockIdx.x);
        pg8::EpiResid<true> E{args.in[IN_X], args.out, proj + F0, LDP, (float*)(ws + WS_RSS)};
        pg8::gemm_phase<pg8::EpiResid<true>, pg8::StaticOrder, false, true>(F.lds + RING_OFF, g, S, E);
        SEAM(5);
    }
    if (IN(6)) {
        p6_meta_tail(F, args); VM_WAIT(); __syncthreads();
        pg8::Gemm g{proj + F0, (const bf16*)(ws + WS_WTUP), MREAL, NUP, DM, LDP, 1 << 30, 0};
        pg8::StaticOrder S; S.init(MREAL, NUP, F.G, (int)blockIdx.x);
        pg8::EpiUp E{proj, (const float*)(ws + WS_RSS), (bf16*)(ws + WS_HALO)};
        pg8::gemm_phase<pg8::EpiUp, pg8::StaticOrder, true, true>(F.lds + RING_OFF, g, S, E);
        SEAM(6);
    }
    if (IN(7)) { p7_conv_glu(F, args); SEAM(7); }
    if (IN(8)) {
        pg8::Gemm g{proj + 2048, (const bf16*)(ws + WS_WTDN), MREAL, DM, DFF, LDP, 1 << 30, 0};
        pg8::StaticOrder S; S.init(MREAL, DM, F.G, (int)blockIdx.x);
        pg8::EpiResid<false> E{args.out, args.out, nullptr, 0, (float*)(ws + WS_SSQ)};
        pg8::gemm_phase<pg8::EpiResid<false>, pg8::StaticOrder, false, true>(F.lds + RING_OFF, g, S, E);
        SEAM(8);
    }
    if (IN(9)) { p9_final_norm(F, args); }
#undef IN
#undef SEAM
}

extern "C" void kernel_launch(void* const* d_in, const int* in_sizes, int n_in, void* d_out, int out_size, void* d_ws, size_t ws_size, hipStream_t stream) {
    static int grid = 0;
    if (grid == 0) {
        if (n_in != 19 || in_sizes[0] != MREAL * DM || out_size != MREAL * DM || ws_size < WS_END) { fprintf(stderr, "kernel_launch: unexpected shapes (n_in %d, in0 %d, out %d, ws %zu); nothing launched\n", n_in, n_in > 0 ? in_sizes[0] : -1, out_size, ws_size); grid = -1; return; }
        int dev = 0, cus = 0;
        if (hipGetDevice(&dev) != hipSuccess || hipDeviceGetAttribute(&cus, hipDeviceAttributeMultiprocessorCount, dev) != hipSuccess) { grid = -1; return; }
        if (hipFuncSetAttribute((const void*)mk_fwd, hipFuncAttributeMaxDynamicSharedMemorySize, LDS_BYTES) != hipSuccess) { fprintf(stderr, "kernel_launch: hipFuncSetAttribute failed\n"); grid = -1; return; }
        (void)hipGetLastError();
        grid = cus;
    }
    if (grid < 0) return;
    if (hipMemsetAsync((char*)d_ws + WS_CTL, 0, CTL_ZERO_BYTES, stream) != hipSuccess) { fprintf(stderr, "kernel_launch: memset failed\n"); return; }
    Args a{};
    for (int i = 0; i < 19; ++i) a.in[i] = (const float*)d_in[i];
    a.out = (float*)d_out; a.ws = (unsigned char*)d_ws;
#if MK_PER_PHASE
    const int phases[] = {0, 1, 2, 3, 4, 5, 6, 7, 8, 9};
    for (int ph : phases) {
        a.ph_lo = ph; a.ph_hi = ph + 1;
        hipLaunchKernelGGL(mk_fwd, dim3(grid), dim3(NWAVES * 64), LDS_BYTES, stream, a);
    }
#else
    a.ph_lo = 0; a.ph_hi = 10;
    hipLaunchKernelGGL(mk_fwd, dim3(grid), dim3(NWAVES * 64), LDS_BYTES, stream, a);
#endif
    const hipError_t le = hipPeekAtLastError();
    if (le != hipSuccess) fprintf(stderr, "kernel_launch: launch failed: %s\n", hipGetErrorName(le));
}
```

```cpp
#include <hip/hip_runtime.h>
#include <cstdio>
#include <cstdint>

#ifndef MK_PER_PHASE
#define MK_PER_PHASE 0
#endif
#ifndef MK_PROBE_LO
#define MK_PROBE_LO (-1)
#define MK_PROBE_HI (-1)
#endif
#ifndef MK_PROBE_MULT
#define MK_PROBE_MULT 4
#endif

namespace pg8 {
#define PG8_LAS __attribute__((address_space(3)))
typedef unsigned short bf16_t;
typedef short bf16x8 __attribute__((ext_vector_type(8)));
typedef float f32x4 __attribute__((ext_vector_type(4)));
typedef unsigned u32x4 __attribute__((ext_vector_type(4)));
constexpr int BM = 256, BK = 64, HALF = 128, HTB = HALF * BK * 2  , STAGE_BYTES = 8 * HTB, NXCD = 8, WGM = 8;

__host__ __device__ __forceinline__ int lds_byte(int r, int c) { const int st = (r >> 4) * 2 + (c >> 5), rr = r & 15, cc = c & 31, ob = rr * 64 + cc * 2; return st * 1024 + (ob ^ (((ob >> 9) & 1) << 5)); }
__host__ __device__ __forceinline__ void stage_rc(int b, int& R, int& C) { const int st = b / 1024, sb = b % 1024, swz = sb ^ (((sb >> 9) & 1) << 5); R = (st >> 1) * 16 + swz / 64; C = (st & 1) * 32 + (swz % 64) / 2; }
__host__ __device__ __forceinline__ int perm32(int rho) { const int n = rho >> 4, i = rho & 15; return 8 * (i >> 2) + 4 * n + (i & 3); }

struct Unit { int pm, pn; };
struct Gemm { const bf16_t* A; const bf16_t* Bt; int M, N, K; int lda; int ksplit; int kjump; };

struct StaticOrder {
    int nM, nN, nwg, G, c;
    __host__ __device__ void init(int M, int N, int G_, int c_) { nM = M / BM; nN = N / BM; nwg = nM * nN; G = G_; c = c_; }
    __host__ __device__ bool next(int i, Unit& u) const {
        const long L = (long)i * G + c; if (L >= nwg) return false;
        int wgid = (int)L; { const int q = nwg / NXCD, r = nwg % NXCD, xcd = wgid % NXCD, off = wgid / NXCD; wgid = (xcd < r ? xcd * (q + 1) : r * (q + 1) + (xcd - r) * q) + off; }
        const int nig = WGM * nN, gid = wgid / nig, fm = gid * WGM, gsz = (nM - fm) < WGM ? (nM - fm) : WGM;
        u.pm = fm + ((wgid % nig) % gsz); u.pn = (wgid % nig) / gsz; return true;
    }
    __device__ __forceinline__ void a_ready(const Unit&) const {}
    __device__ __forceinline__ void done(const Unit&) const {}
};

__device__ __forceinline__ unsigned cvt_pk_bf16(float lo, float hi) { unsigned r; asm volatile("v_cvt_pk_bf16_f32 %0, %1, %2" : "=v"(r) : "v"(lo), "v"(hi)); return r; }
__device__ __forceinline__ u32x4 pack8(const f32x4 v0, const f32x4 v1) { u32x4 w; w.x = cvt_pk_bf16(v0[0], v0[1]); w.y = cvt_pk_bf16(v0[2], v0[3]); w.z = cvt_pk_bf16(v1[0], v1[1]); w.w = cvt_pk_bf16(v1[2], v1[3]); return w; }

__device__ __forceinline__ float ep_silu(float x) { return x * __builtin_amdgcn_rcpf(1.0f + __expf(-x)); }
struct EpiProj {
    static constexpr bool PERM = true, AFTER_DRAIN = false;
    bf16_t* O; int ldc; const float* lbl; const float* dtb;
    __device__ __forceinline__ void operator()(const f32x4 (&acc)[2][2][4][2], const Unit& u, int wr, int wc, int fr, int fq) const {
        const int row0 = u.pm * BM + wr * 64 + fr, col0 = u.pn * BM + wc * 32 + 8 * fq;
        const int kind = (u.pn < 4) ? 1 : (u.pn < 8 ? 2 : (u.pn < 12 ? 0 : (u.pn < 20 ? 1 : (u.pn == 26 ? 3 : 0))));
        float par[2][8];
        if (kind == 2) {
#pragma unroll
            for (int bj = 0; bj < 2; ++bj)
#pragma unroll
                for (int j = 0; j < 8; ++j) { const int c = col0 + bj * HALF + j - 1024; par[bj][j] = __builtin_amdgcn_rcpf(1.0f + __expf(lbl[1024 + c] - lbl[c])); }
        } else if (kind == 3) {
#pragma unroll
            for (int bj = 0; bj < 2; ++bj)
#pragma unroll
                for (int j = 0; j < 8; ++j) { const int c = col0 + bj * HALF + j - 6656; par[bj][j] = (c >= 0 && c < 16) ? dtb[c] : 0.f; }
        }
#pragma unroll
        for (int ai = 0; ai < 2; ++ai)
#pragma unroll
            for (int m = 0; m < 4; ++m) { bf16_t* rowp = O + (size_t)(row0 + ai * HALF + m * 16) * ldc + col0;
#pragma unroll
                for (int bj = 0; bj < 2; ++bj) { f32x4 v0 = acc[ai][bj][m][0], v1 = acc[ai][bj][m][1];
                    if (kind == 1) {
#pragma unroll
                        for (int j = 0; j < 4; ++j) { v0[j] = ep_silu(v0[j]); v1[j] = ep_silu(v1[j]); }
                    } else if (kind == 2) {
#pragma unroll
                        for (int j = 0; j < 4; ++j) { const float l0 = par[bj][j], l1 = par[bj][4 + j];
                            v0[j] = __logf(l0 + (1.0f - l0) * __builtin_amdgcn_rcpf(1.0f + __expf(-v0[j]))); v1[j] = __logf(l1 + (1.0f - l1) * __builtin_amdgcn_rcpf(1.0f + __expf(-v1[j]))); }
                    } else if (kind == 3) {
#pragma unroll
                        for (int j = 0; j < 4; ++j) { const float x0 = v0[j] + par[bj][j], x1 = v1[j] + par[bj][4 + j]; const float u0 = __expf(x0), u1 = __expf(x1);
                            const float s0 = u0 * (1.0f - u0 * (0.5f - u0 * (0.33333334f - u0 * 0.25f))), s1 = u1 * (1.0f - u1 * (0.5f - u1 * (0.33333334f - u1 * 0.25f)));
                            v0[j] = x0 > 20.f ? x0 : (u0 < 0.0625f ? s0 : __logf(1.0f + u0)); v1[j] = x1 > 20.f ? x1 : (u1 < 0.0625f ? s1 : __logf(1.0f + u1)); }
                    }
                    *(u32x4*)(rowp + bj * HALF) = pack8(v0, v1); } }
    }
};
template <bool WRITE_A2> struct EpiResid {
    static constexpr bool PERM = true, AFTER_DRAIN = false;
    const float* base; float* out; bf16_t* a2; int lda2; float* rss;
    __device__ __forceinline__ void operator()(const f32x4 (&acc)[2][2][4][2], const Unit& u, int wr, int wc, int fr, int fq) const {
        const int row0 = u.pm * BM + wr * 64 + fr, col0 = u.pn * BM + wc * 32 + 8 * fq;
#pragma unroll
        for (int ai = 0; ai < 2; ++ai)
#pragma unroll
            for (int m = 0; m < 4; ++m) { const int row = row0 + ai * HALF + m * 16; float ss = 0.f;
#pragma unroll
                for (int bj = 0; bj < 2; ++bj) { const size_t o = (size_t)row * 1024 + col0 + bj * HALF;
                    const f32x4 v0 = acc[ai][bj][m][0] + *(const f32x4*)(base + o), v1 = acc[ai][bj][m][1] + *(const f32x4*)(base + o + 4);
                    *(f32x4*)(out + o) = v0; *(f32x4*)(out + o + 4) = v1;
                    ss += (v0[0] * v0[0] + v0[1] * v0[1]) + (v0[2] * v0[2] + v0[3] * v0[3]) + (v1[0] * v1[0] + v1[1] * v1[1]) + (v1[2] * v1[2] + v1[3] * v1[3]);
                    if (WRITE_A2) *(u32x4*)(a2 + (size_t)row * lda2 + col0 + bj * HALF) = pack8(v0, v1); }
                ss += __shfl_xor(ss, 16); ss += __shfl_xor(ss, 32);
                if (fq == 0) rss[(size_t)row * 16 + u.pn * 4 + wc] = ss; }
    }
};
struct EpiUp {
    static constexpr bool PERM = true, AFTER_DRAIN = false;
    bf16_t* proj; const float* rss; bf16_t* halo;
    __device__ __forceinline__ void operator()(const f32x4 (&acc)[2][2][4][2], const Unit& u, int wr, int wc, int fr, int fq) const {
        const int row0 = u.pm * BM + wr * 64 + fr, jc = u.pn * 128 + wc * 32 + 8 * fq;
        const int dcol[2] = { 2048 + jc, (u.pn < 8) ? jc : jc + 3840 };
#pragma unroll
        for (int ai = 0; ai < 2; ++ai)
#pragma unroll
            for (int m = 0; m < 4; ++m) { const int row = row0 + ai * HALF + m * 16;
                const f32x4* rp = (const f32x4*)(rss + (size_t)row * 16); const f32x4 a = rp[0], b = rp[1], c = rp[2], d = rp[3];
                const float tot = (((a[0] + a[1]) + (a[2] + a[3])) + ((b[0] + b[1]) + (b[2] + b[3]))) + (((c[0] + c[1]) + (c[2] + c[3])) + ((d[0] + d[1]) + (d[2] + d[3])));
                const float rs = 1.0f / sqrtf(tot * (1.0f / 1024.0f) + 1e-6f);
#pragma unroll
                for (int bj = 0; bj < 2; ++bj) { const u32x4 w = pack8(acc[ai][bj][m][0] * rs, acc[ai][bj][m][1] * rs);
                    *(u32x4*)(proj + (size_t)row * 6912 + dcol[bj]) = w;
                    if ((row & 63) >= 62) *(u32x4*)(halo + (size_t)((row >> 6) * 2 + (row & 1)) * 5632 + bj * 2816 + jc) = w; } }
    }
};

template <class Epi, class Sched, bool ALIGN_EPI = false, bool SP2 = false>
__device__ __forceinline__ void gemm_phase(PG8_LAS unsigned char* lds, const Gemm g, const Sched& S, const Epi& E) {
    const int tid = threadIdx.x, wid = __builtin_amdgcn_readfirstlane(tid >> 6), lane = tid & 63, wr = wid >> 2, wc = wid & 3, fr = lane & 15, fq = lane >> 4;
    const int K = g.K, nt = K / BK, lda = g.lda;
    unsigned voffA[2], voffB[2];
#pragma unroll
    for (int i = 0; i < 2; ++i) { int R, C; stage_rc(tid * 16 + i * 8192, R, C); const int Rb = Epi::PERM ? ((R & ~31) + perm32(R & 31)) : R;
        voffA[i] = (unsigned)(R * lda + C) * 2u; voffB[i] = (unsigned)(Rb * K + C) * 2u; }
    const size_t kstep = (size_t)(BK * 2);
    const size_t hstepA = (size_t)HALF * lda * 2, tstepA = 2 * hstepA;
    const size_t hstepB = (size_t)HALF * K * 2, tstepB = 2 * hstepB;
    const int ksplit = g.ksplit; const size_t kjump = (size_t)g.kjump;
#define PG8_AK(kt) ((size_t)(kt) * kstep + (((kt) >= ksplit) ? kjump : (size_t)0))
    const unsigned ldsw = (unsigned)wid * 1024u;
    const int aoff = lds_byte(wr * 64 + fr, fq * 8), boff = lds_byte(wc * 32 + fr, fq * 8);
#define PG8_SA(b, h) (((b) * 2 + (h)) * HTB)
#define PG8_SB(b, h) ((4 + (b) * 2 + (h)) * HTB)
#define PG8_STAGE(bufoff, gbase, voff) do { _Pragma("unroll") for (int _i = 0; _i < 2; ++_i) \
        __builtin_amdgcn_global_load_lds((const unsigned*)((const char*)(gbase) + (voff)[_i]), (PG8_LAS unsigned*)(lds + (bufoff) + ldsw + _i * 8192), 16, 0, 0); } while (0)
#define PG8_LDA(dst, b, h) do { _Pragma("unroll") for (int m = 0; m < 4; ++m) _Pragma("unroll") for (int k = 0; k < 2; ++k) dst[m][k] = *(const PG8_LAS bf16x8*)(lds + PG8_SA(b, h) + aoff + m * 2048 + k * 1024); } while (0)
#define PG8_LDB(dst, b, h) do { _Pragma("unroll") for (int n = 0; n < 2; ++n) _Pragma("unroll") for (int k = 0; k < 2; ++k) dst[n][k] = *(const PG8_LAS bf16x8*)(lds + PG8_SB(b, h) + boff + n * 2048 + k * 1024); } while (0)
#define PG8_MMA(ai, bj, At, Bt) do { __builtin_amdgcn_s_setprio(1); _Pragma("unroll") for (int m = 0; m < 4; ++m) _Pragma("unroll") for (int n = 0; n < 2; ++n) _Pragma("unroll") for (int k = 0; k < 2; ++k) \
        acc[ai][bj][m][n] = __builtin_amdgcn_mfma_f32_16x16x32_bf16(Bt[n][k], At[m][k], acc[ai][bj][m][n], 0, 0, 0); __builtin_amdgcn_s_setprio(0); } while (0)
#define PG8_WAIT_V(n) asm volatile("s_waitcnt vmcnt(" #n ")" ::: "memory")
#define PG8_WAIT_L(n) asm volatile("s_waitcnt lgkmcnt(" #n ")" ::: "memory")
#define PG8_BAR __builtin_amdgcn_s_barrier()
#define PG8_SCHED __builtin_amdgcn_sched_barrier(0)
    Unit cur, nxt; int ui = 0;
    if (!S.next(0, cur)) return;
    f32x4 acc[2][2][4][2];
#pragma unroll
    for (int a = 0; a < 2; ++a)
#pragma unroll
        for (int b = 0; b < 2; ++b)
#pragma unroll
            for (int m = 0; m < 4; ++m)
#pragma unroll
                for (int n = 0; n < 2; ++n) acc[a][b][m][n] = (f32x4){0.f, 0.f, 0.f, 0.f};
    bf16x8 At[4][2], B0[2][2], B1[2][2];
    const char* cA = (const char*)g.A + (size_t)cur.pm * tstepA; const char* cB = (const char*)g.Bt + (size_t)cur.pn * tstepB;
    S.a_ready(cur);
    if constexpr (SP2) {
        PG8_STAGE(PG8_SB(0, 0), cB, voffB); PG8_STAGE(PG8_SB(0, 1), cB + hstepB, voffB); PG8_STAGE(PG8_SA(0, 0), cA, voffA); PG8_STAGE(PG8_SA(0, 1), cA + hstepA, voffA);
        if (wr == 1) PG8_BAR;
        PG8_WAIT_V(2); PG8_BAR;
        PG8_STAGE(PG8_SB(1, 0), cB + kstep, voffB); PG8_STAGE(PG8_SA(1, 0), cA + PG8_AK(1), voffA); PG8_STAGE(PG8_SB(1, 1), cB + hstepB + kstep, voffB);
        PG8_WAIT_V(6); PG8_BAR;
    } else {
        PG8_STAGE(PG8_SB(0, 0), cB, voffB); PG8_STAGE(PG8_SA(0, 0), cA, voffA); PG8_STAGE(PG8_SB(0, 1), cB + hstepB, voffB); PG8_STAGE(PG8_SA(0, 1), cA + hstepA, voffA);
        if (wr == 1) PG8_BAR;
        PG8_WAIT_V(4); PG8_BAR;
        PG8_STAGE(PG8_SB(1, 0), cB + kstep, voffB); PG8_STAGE(PG8_SA(1, 0), cA + PG8_AK(1), voffA); PG8_STAGE(PG8_SB(1, 1), cB + hstepB + kstep, voffB);
        PG8_WAIT_V(6); PG8_BAR;
    }
    for (;;) {
        const bool has_next = S.next(ui + 1, nxt);
        const char* nA = has_next ? (const char*)g.A + (size_t)nxt.pm * tstepA : cA; const char* nB = has_next ? (const char*)g.Bt + (size_t)nxt.pn * tstepB : cB;
        for (int t = 0; t < nt; t += 2) {
            const bool last = (t == nt - 2);
            const char* a1 = cA + PG8_AK(t + 1);
            const char* a2 = last ? nA : cA + PG8_AK(t + 2); const char* b2 = last ? nB : cB + (size_t)(t + 2) * kstep;
            const char* a3 = last ? nA + PG8_AK(1) : cA + PG8_AK(t + 3); const char* b3 = b2 + kstep;
            if (last && has_next) S.a_ready(nxt);
            if constexpr (SP2) {
            PG8_LDB(B0, 0, 0); PG8_LDB(B1, 0, 1); PG8_SCHED; PG8_LDA(At, 0, 0); PG8_STAGE(PG8_SA(1, 1), a1 + hstepA, voffA);
            PG8_WAIT_V(8); PG8_WAIT_L(0); PG8_BAR; PG8_MMA(0, 0, At, B0); PG8_MMA(0, 1, At, B1); PG8_BAR; PG8_SCHED;
            PG8_LDA(At, 0, 1); PG8_STAGE(PG8_SB(0, 0), b2, voffB); PG8_STAGE(PG8_SB(0, 1), b2 + hstepB, voffB); PG8_STAGE(PG8_SA(0, 0), a2, voffA);
            PG8_WAIT_V(8); PG8_WAIT_L(0); PG8_BAR; PG8_MMA(1, 0, At, B0); PG8_MMA(1, 1, At, B1); PG8_BAR; PG8_SCHED;
            PG8_LDB(B0, 1, 0); PG8_LDB(B1, 1, 1); PG8_SCHED; PG8_LDA(At, 1, 0); PG8_STAGE(PG8_SA(0, 1), a2 + hstepA, voffA);
            PG8_WAIT_V(8); PG8_WAIT_L(0); PG8_BAR; PG8_MMA(0, 0, At, B0); PG8_MMA(0, 1, At, B1); PG8_BAR; PG8_SCHED;
            PG8_LDA(At, 1, 1); PG8_STAGE(PG8_SB(1, 0), b3, voffB); PG8_STAGE(PG8_SB(1, 1), b3 + hstepB, voffB); PG8_STAGE(PG8_SA(1, 0), a3, voffA);
            PG8_WAIT_V(8); PG8_WAIT_L(0); PG8_BAR; PG8_MMA(1, 0, At, B0); PG8_MMA(1, 1, At, B1); PG8_BAR; PG8_SCHED;
            } else {
            PG8_LDB(B0, 0, 0); PG8_SCHED; PG8_LDA(At, 0, 0); PG8_STAGE(PG8_SA(1, 1), a1 + hstepA, voffA);
            PG8_WAIT_L(8); PG8_BAR; PG8_WAIT_L(0); PG8_MMA(0, 0, At, B0); PG8_BAR; PG8_SCHED;
            PG8_LDB(B1, 0, 1); PG8_STAGE(PG8_SB(0, 0), b2, voffB);
            PG8_BAR; PG8_WAIT_L(0); PG8_MMA(0, 1, At, B1); PG8_BAR;
            PG8_LDA(At, 0, 1); PG8_STAGE(PG8_SA(0, 0), a2, voffA);
            PG8_BAR; PG8_WAIT_L(0); PG8_MMA(1, 0, At, B0); PG8_BAR; PG8_SCHED;
            PG8_STAGE(PG8_SB(0, 1), b2 + hstepB, voffB);
            PG8_WAIT_V(6); PG8_BAR; PG8_MMA(1, 1, At, B1); PG8_BAR;
            PG8_LDB(B0, 1, 0); PG8_SCHED; PG8_LDA(At, 1, 0); PG8_STAGE(PG8_SA(0, 1), a2 + hstepA, voffA);
            PG8_WAIT_L(8); PG8_BAR; PG8_WAIT_L(0); PG8_MMA(0, 0, At, B0); PG8_BAR; PG8_SCHED;
            PG8_LDB(B1, 1, 1); PG8_STAGE(PG8_SB(1, 0), b3, voffB);
            PG8_BAR; PG8_WAIT_L(0); PG8_MMA(0, 1, At, B1); PG8_BAR;
            PG8_LDA(At, 1, 1); PG8_STAGE(PG8_SA(1, 0), a3, voffA);
            PG8_BAR; PG8_WAIT_L(0); PG8_MMA(1, 0, At, B0); PG8_BAR; PG8_SCHED;
            PG8_STAGE(PG8_SB(1, 1), b3 + hstepB, voffB);
            PG8_WAIT_V(6); PG8_BAR; PG8_MMA(1, 1, At, B1); PG8_BAR;
            }
        }
        if constexpr (ALIGN_EPI) { if (wr == 0) PG8_BAR; }
        if constexpr (!Epi::AFTER_DRAIN) { E(acc, cur, wr, wc, fr, fq); S.done(cur); }
        if (!has_next) break;
#pragma unroll
        for (int a = 0; a < 2; ++a)
#pragma unroll
            for (int b = 0; b < 2; ++b)
#pragma unroll
                for (int m = 0; m < 4; ++m)
#pragma unroll
                    for (int n = 0; n < 2; ++n) acc[a][b][m][n] = (f32x4){0.f, 0.f, 0.f, 0.f};
        cur = nxt; cA = nA; cB = nB; ++ui;
        if constexpr (ALIGN_EPI) { if (wr == 1) PG8_BAR; }
    }
    PG8_WAIT_V(0);
    if constexpr (!ALIGN_EPI) { if (wr == 0) PG8_BAR; }
    PG8_BAR;
#undef PG8_AK
#undef PG8_SA
#undef PG8_SB
#undef PG8_STAGE
#undef PG8_LDA
#undef PG8_LDB
#undef PG8_MMA
#undef PG8_WAIT_V
#undef PG8_WAIT_L
#undef PG8_BAR
#undef PG8_SCHED
}
}

constexpr int NWAVES = 8;
constexpr int NB = 4, SEQ = 4096, DM = 1024, NMETA = 16;
constexpr int MREAL = NB * SEQ;
constexpr int MROWS = MREAL + NMETA;
constexpr int M1 = 16640;
constexpr int NPROJ = 6672, LDP = 6912;
constexpr int Q0 = 0, F0 = 1024, I0 = 2048, G0 = 3072, Z0 = 4096, XBC0 = 5120, DT0 = 6656;
constexpr int DFF = 2816, NUP = 2 * DFF;
constexpr float EPS = 1e-6f;

constexpr size_t MiB = 1u << 20;
constexpr size_t WS_CTL = 0, CTL_ZERO_BYTES = 1 * MiB;
constexpr size_t WS_WTOUT = 1 * MiB;
constexpr size_t WS_WTUP = 5 * MiB;
constexpr size_t WS_WTDN = 16 * MiB;
constexpr size_t WS_SSQ = 22 * MiB;
constexpr size_t WS_RSS = 23 * MiB + 512 * 1024;
constexpr size_t WS_MIXMETA = 24 * MiB + 512 * 1024;
constexpr size_t WS_H2M = WS_MIXMETA + 64 * 1024;
constexpr size_t WS_PMETA = WS_H2M + 16 * 1024;
constexpr size_t WS_HALO = 25 * MiB;
constexpr size_t WS_PROJ = 31 * MiB;
constexpr size_t WS_END = WS_PROJ + (size_t)M1 * LDP * 2;
static_assert(WS_END <= 256 * MiB, "d_ws map");
constexpr size_t DO_U = 0, DO_WTIN = 34 * MiB;
static_assert(DO_WTIN + (size_t)LDP * DM * 2 <= 64 * MiB && (size_t)M1 * DM * 2 <= DO_WTIN, "d_out scratch map");
constexpr int CW_BAR = 4096;

constexpr int RING_OFF = 0, RING_BYTES = 131072;
constexpr int LDSCTL_OFF = RING_BYTES, MISC_OFF = LDSCTL_OFF + 320;
constexpr int LDS_BYTES = 147456;

#define GAS __attribute__((address_space(1)))
#define LAS __attribute__((address_space(3)))
typedef unsigned short bf16;
typedef unsigned v4u __attribute__((ext_vector_type(4)));
typedef float f32x4 __attribute__((ext_vector_type(4)));
typedef short bf16x8 __attribute__((ext_vector_type(8)));
typedef GAS unsigned gu32;
#define RLX_AGENT __ATOMIC_RELAXED, __HIP_MEMORY_SCOPE_AGENT
#define LDS_WAIT() asm volatile("s_waitcnt lgkmcnt(0)" ::: "memory")
#define VM_WAIT() asm volatile("s_waitcnt vmcnt(0)" ::: "memory")
__device__ __forceinline__ unsigned f2bf(float f) { unsigned u = __builtin_bit_cast(unsigned, f); return (u + 0x7fffu + ((u >> 16) & 1u)) >> 16; }
typedef float f32x2_t_ __attribute__((ext_vector_type(2)));
typedef __bf16 bf16x2_t_ __attribute__((ext_vector_type(2)));
__device__ __forceinline__ unsigned pk2(float lo, float hi) { const f32x2_t_ v = {lo, hi}; const bf16x2_t_ b = __builtin_convertvector(v, bf16x2_t_); return __builtin_bit_cast(unsigned, b); }
__device__ __forceinline__ float bf2f(unsigned short b) { return __builtin_bit_cast(float, ((unsigned)b) << 16); }
__device__ __forceinline__ float bflo(unsigned w) { return __builtin_bit_cast(float, w << 16); }
__device__ __forceinline__ float bfhi(unsigned w) { return __builtin_bit_cast(float, w & 0xffff0000u); }
__device__ __forceinline__ float sigmoidf_(float x) { return __builtin_amdgcn_rcpf(1.0f + __expf(-x)); }
__device__ __forceinline__ float siluf_(float x) { return x * __builtin_amdgcn_rcpf(1.0f + __expf(-x)); }
__device__ __forceinline__ float softplusf_(float x) { const float u = __expf(x); const float ser = u * (1.0f - u * (0.5f - u * (0.33333334f - u * 0.25f))); return x > 20.f ? x : (u < 0.0625f ? ser : __logf(1.0f + u)); }

#define XB_TMO      128
#define XB_XCNT(j)  (256  + 64 * (j))
#define XB_XSUB(j)  (1280 + 64 * (j))
#define XB_XGEN(j)  (2304 + 64 * (j))
#define XB_TOP      3328
#define XB_TOPGEN   3392
#define XCD_BAR_WORDS 3456
#define XB_SPIN_CAP (1u << 18)
__device__ __forceinline__ unsigned xb_ld(unsigned* p)              { return __hip_atomic_load(p, __ATOMIC_RELAXED, __HIP_MEMORY_SCOPE_AGENT); }
__device__ __forceinline__ unsigned xb_add(unsigned* p, unsigned v) { return __hip_atomic_fetch_add(p, v, __ATOMIC_RELAXED, __HIP_MEMORY_SCOPE_AGENT); }
__device__ __forceinline__ unsigned xb_xcc_id() { return (unsigned)__builtin_amdgcn_s_getreg((3 << 11) | 20) & 0xFu; }
#define XB_SPIN(cond, bar) do { unsigned _sp = 0; while (cond) { __builtin_amdgcn_s_sleep(1); \
    if ((++_sp & 255u) == 0u) { if (xb_ld(&(bar)[XB_TMO])) break; if (_sp > XB_SPIN_CAP) { atomicAdd(&(bar)[XB_TMO], 1u); break; } } } } while (0)
struct XcdBarrier { unsigned* bar; unsigned x; volatile LAS unsigned* st; };
__device__ __forceinline__ XcdBarrier xcd_barrier_post(unsigned* bar, volatile LAS unsigned* st) {
    XcdBarrier b; b.bar = bar; b.x = xb_xcc_id(); b.st = st;
    if (threadIdx.x == 0) (void)xb_add(&bar[XB_XCNT(b.x)], 1u);
    return b;
}
__device__ __forceinline__ void xcd_barrier_complete(unsigned* bar, unsigned x, unsigned& nloc, unsigned& nx) {
    const unsigned G = gridDim.x * gridDim.y * gridDim.z;
    unsigned sum, cnt, mine, sp = 0u;
    for (;;) {
        sum = 0u; cnt = 0u; mine = 0u;
#pragma unroll
        for (unsigned j = 0; j < 16; ++j) { const unsigned c = xb_ld(&bar[XB_XCNT(j)]); sum += c; cnt += (c > 0u) ? 1u : 0u; mine = (j == x) ? c : mine; }
        if (sum == G) break;
        __builtin_amdgcn_s_sleep(1);
        if ((++sp & 255u) == 0u) { if (xb_ld(&bar[XB_TMO])) break; if (sp > XB_SPIN_CAP) { atomicAdd(&bar[XB_TMO], 1u); break; } }
    }
    nloc = mine > 0u ? mine : 1u; nx = cnt > 0u ? cnt : 1u;
}
__device__ __forceinline__ void xcd_barrier(const XcdBarrier& b) {
    asm volatile("s_waitcnt vmcnt(0)" ::: "memory");
    __syncthreads();
    if (threadIdx.x == 0) {
        unsigned* bar = b.bar;
        __builtin_amdgcn_s_waitcnt(0);
        unsigned nloc = b.st[0], nx = b.st[1];
        if (nloc == 0u) { xcd_barrier_complete(bar, b.x, nloc, nx); b.st[0] = nloc; b.st[1] = nx; }
        const unsigned old = xb_add(&bar[XB_XSUB(b.x)], 1u);
        const unsigned gen = old / nloc;
        if (old + 1u == (gen + 1u) * nloc) {
            __builtin_amdgcn_fence(__ATOMIC_RELEASE, "agent");
            asm volatile("s_waitcnt vmcnt(0)" ::: "memory");
            const unsigned og = xb_add(&bar[XB_TOP], 1u);
            const unsigned tg = og / nx;
            if (og + 1u == (tg + 1u) * nx) xb_add(&bar[XB_TOPGEN], 1u);
            else XB_SPIN(xb_ld(&bar[XB_TOPGEN]) == tg, bar);
            __builtin_amdgcn_fence(__ATOMIC_ACQUIRE, "agent");
            xb_add(&bar[XB_XGEN(b.x)], 1u);
            asm volatile("s_waitcnt vmcnt(0)" ::: "memory");
        } else {
            XB_SPIN(xb_ld(&bar[XB_XGEN(b.x)]) == gen, bar);
            __builtin_amdgcn_fence(__ATOMIC_ACQUIRE, "agent");
            asm volatile("s_waitcnt vmcnt(0)" ::: "memory");
        }
    }
    __syncthreads();
}

struct Args { const float* in[19]; float* out; unsigned char* ws; int ph_lo, ph_hi; };
enum { IN_X = 0, IN_META, IN_N1W, IN_WIN, IN_LBL, IN_HGNW, IN_CW, IN_CB, IN_DTB, IN_ALOG, IN_D, IN_M2NW, IN_WOUT, IN_N2W, IN_WUP, IN_FCW, IN_FCB, IN_WDN, IN_FNW };

struct Frame {
    LAS unsigned char* lds;
    int tid, lane, wave, vcu, G;
};

__device__ __forceinline__ float wave_sum(float v) {
#pragma unroll
    for (int o = 1; o < 64; o <<= 1) v += __shfl_xor(v, o);
    return v;
}

__device__ __forceinline__ void p0_transpose_item(const float* W, int K, int N, int nvalid, bf16* WT, int drow0, int scol0, int k0, const float* kscale, LAS float* scr, int lane) {
    const int c = scol0 + (lane & 31);
#pragma unroll 8
    for (int i = 0; i < 32; ++i) { const int kk = 2 * i + (lane >> 5); float v = (c < nvalid) ? W[(size_t)(k0 + kk) * N + c] : 0.f; if (kscale) v *= kscale[k0 + kk]; scr[kk * 33 + (lane & 31)] = v; }
    LDS_WAIT(); asm volatile("" ::: "memory");
    const int ch = lane & 7;
#pragma unroll
    for (int j = 0; j < 4; ++j) { const int n = (lane >> 3) + 8 * j; const LAS float* s = scr + (8 * ch) * 33 + n;
        v4u o; o.x = pk2(s[0 * 33], s[1 * 33]); o.y = pk2(s[2 * 33], s[3 * 33]); o.z = pk2(s[4 * 33], s[5 * 33]); o.w = pk2(s[6 * 33], s[7 * 33]);
        *(GAS v4u*)(WT + (size_t)(drow0 + n) * K + k0 + 8 * ch) = o; }
    LDS_WAIT(); asm volatile("" ::: "memory");
}
__device__ __forceinline__ void rms_row_to_bf16(int lane, const float* xrow, const float* w, bf16* orow) {
    GAS unsigned long long* o8 = (GAS unsigned long long*)orow + lane;
    if (xrow == nullptr) {
#pragma unroll
        for (int j = 0; j < 4; ++j) o8[64 * j] = 0ull;
        return; }
    const GAS f32x4* xr = (const GAS f32x4*)xrow + lane; const GAS f32x4* wr = (const GAS f32x4*)w + lane;
    f32x4 v[4]; float s = 0.f;
#pragma unroll
    for (int j = 0; j < 4; ++j) { v[j] = xr[64 * j]; s += (v[j].x * v[j].x + v[j].y * v[j].y) + (v[j].z * v[j].z + v[j].w * v[j].w); }
    const float rs = 1.f / sqrtf(wave_sum(s) * (1.f / DM) + EPS);
#pragma unroll
    for (int j = 0; j < 4; ++j) { const f32x4 ww = wr[64 * j]; o8[64 * j] = (unsigned long long)pk2(v[j].x * rs * ww.x, v[j].y * rs * ww.y) | ((unsigned long long)pk2(v[j].z * rs * ww.z, v[j].w * rs * ww.w) << 32); }
}

__device__ __forceinline__ void p0_prologue(const Frame& F, const Args& a) {
    LAS float* scr = (LAS float*)(F.lds + RING_OFF + F.wave * 16384);
    const int gw = F.vcu * NWAVES + F.wave, NGW = F.G * NWAVES;
    bf16* WTin = (bf16*)((unsigned char*)a.out + DO_WTIN); bf16* WTout = (bf16*)(a.ws + WS_WTOUT); bf16* WTup = (bf16*)(a.ws + WS_WTUP); bf16* WTdn = (bf16*)(a.ws + WS_WTDN);
    constexpr int I_IN = (LDP / 32) * (DM / 64), I_OUT = (DM / 32) * (2048 / 64), I_UP = (NUP / 32) * (DM / 64), I_DN = (DM / 32) * (DFF / 64);
    constexpr int NITEMS = I_IN + I_OUT + I_UP + I_DN;
    for (int it = gw; it < NITEMS; it += NGW) {
        int r = it;
        if (r < I_IN) { const int nb = r % (LDP / 32), kb = r / (LDP / 32); p0_transpose_item(a.in[IN_WIN], DM, NPROJ, NPROJ, WTin, nb * 32, nb * 32, kb * 64, nullptr, scr, F.lane); continue; } r -= I_IN;
        if (r < I_OUT) { const int nb = r % (DM / 32), kb = r / (DM / 32); p0_transpose_item(a.in[IN_WOUT], 2048, DM, DM, WTout, nb * 32, nb * 32, kb * 64, nullptr, scr, F.lane); continue; } r -= I_OUT;
        if (r < I_UP) { const int nb = r % (NUP / 32), kb = r / (NUP / 32); const int d0 = nb * 32, pn = d0 >> 8, rem = d0 & 255, bj = rem >> 7, j = rem & 127;
            p0_transpose_item(a.in[IN_WUP], DM, NUP, NUP, WTup, d0, bj * DFF + pn * 128 + j, kb * 64, a.in[IN_N2W], scr, F.lane); continue; } r -= I_UP;
        { const int nb = r % (DM / 32), kb = r / (DM / 32); p0_transpose_item(a.in[IN_WDN], DFF, DM, DM, WTdn, nb * 32, nb * 32, kb * 64, nullptr, scr, F.lane); }
    }
    bf16* U = (bf16*)((unsigned char*)a.out + DO_U);
    for (int m = gw; m < M1; m += NGW) {
        const float* src = (m < MREAL) ? a.in[IN_X] + (size_t)m * DM : (m < MROWS ? a.in[IN_META] + (size_t)(m - MREAL) * DM : nullptr);
        rms_row_to_bf16(F.lane, src, a.in[IN_N1W], U + (size_t)m * DM);
    }
}

__device__ __forceinline__ void p4_groupnorm(const Frame& F, const Args& a) {
    const int gw = F.vcu * NWAVES + F.wave, NGW = F.G * NWAVES;
    bf16* proj = (bf16*)(a.ws + WS_PROJ); bf16* mixmeta = (bf16*)(a.ws + WS_MIXMETA); const float* ssq = (const float*)(a.ws + WS_SSQ);
    for (int m = gw; m < MROWS; m += NGW) {
        bf16* p = (m < MREAL) ? proj + (size_t)m * LDP + Z0 : mixmeta + (size_t)(m - MREAL) * 2048 + 1024;
        const int g = F.lane >> 5; const f32x4* sp = (const f32x4*)(ssq + (size_t)m * 16 + g * 8); const f32x4 s0 = sp[0], s1 = sp[1];
        const float tot = ((s0[0] + s0[1]) + (s0[2] + s0[3])) + ((s1[0] + s1[1]) + (s1[2] + s1[3]));
        const float sc = 1.f / sqrtf(tot * (1.f / 512.f) + EPS);
        v4u* q = (v4u*)(p + F.lane * 16);
#pragma unroll
        for (int j = 0; j < 2; ++j) { v4u w = q[j]; v4u o;
            o.x = pk2(bflo(w.x) * sc, bfhi(w.x) * sc); o.y = pk2(bflo(w.y) * sc, bfhi(w.y) * sc); o.z = pk2(bflo(w.z) * sc, bfhi(w.z) * sc); o.w = pk2(bflo(w.w) * sc, bfhi(w.w) * sc); q[j] = o; }
    }
}
__device__ __forceinline__ float wave_dot_bf16(const bf16* x, const bf16* w, int n, int lane) {
    float s = 0.f;
    for (int i = lane * 8; i < n; i += 512) { const v4u a = *(const v4u*)(x + i), b = *(const v4u*)(w + i);
        s += bflo(a.x) * bflo(b.x) + bfhi(a.x) * bfhi(b.x) + bflo(a.y) * bflo(b.y) + bfhi(a.y) * bfhi(b.y) + bflo(a.z) * bflo(b.z) + bfhi(a.z) * bfhi(b.z) + bflo(a.w) * bflo(b.w) + bfhi(a.w) * bfhi(b.w); }
    return wave_sum(s);
}
__device__ __forceinline__ void p5_meta_tail(const Frame& F, const Args& a) {
    const int gw = F.vcu * NWAVES + F.wave, NGW = F.G * NWAVES;
    const bf16* mixmeta = (const bf16*)(a.ws + WS_MIXMETA); const bf16* WTout = (const bf16*)(a.ws + WS_WTOUT); float* h2m = (float*)(a.ws + WS_H2M);
    for (int o = gw; o < 2 * DM; o += NGW) { const int i = o / DM, n = o % DM;
        const float d = wave_dot_bf16(mixmeta + (size_t)(14 + i) * 2048, WTout + (size_t)n * 2048, 2048, F.lane);
        if (F.lane == 0) h2m[o] = a.in[IN_META][(size_t)(14 + i) * DM + n] + d; }
}
__device__ __forceinline__ void p6_meta_tail(const Frame& F, const Args& a) {
    const int gw = F.vcu * NWAVES + F.wave, NGW = F.G * NWAVES;
    const bf16* WTup = (const bf16*)(a.ws + WS_WTUP); const float* h2m = (const float*)(a.ws + WS_H2M); float* pmeta = (float*)(a.ws + WS_PMETA);
    for (int o = gw; o < 2 * NUP; o += NGW) { const int i = o / NUP, c = o % NUP; const int isv = c >= DFF, cc = isv ? c - DFF : c, n = (cc >> 7) * 256 + isv * 128 + (cc & 127);
        const float* h = h2m + (size_t)i * DM; const bf16* w = WTup + (size_t)n * DM; float s = 0.f, ss = 0.f;
        for (int k = F.lane * 8; k < DM; k += 512) { const f32x4 h0 = *(const f32x4*)(h + k), h1 = *(const f32x4*)(h + k + 4); const v4u b = *(const v4u*)(w + k);
            ss += (h0[0] * h0[0] + h0[1] * h0[1]) + (h0[2] * h0[2] + h0[3] * h0[3]) + (h1[0] * h1[0] + h1[1] * h1[1]) + (h1[2] * h1[2] + h1[3] * h1[3]);
            s += bf2f(f2bf(h0[0])) * bflo(b.x) + bf2f(f2bf(h0[1])) * bfhi(b.x) + bf2f(f2bf(h0[2])) * bflo(b.y) + bf2f(f2bf(h0[3])) * bfhi(b.y)
               + bf2f(f2bf(h1[0])) * bflo(b.z) + bf2f(f2bf(h1[1])) * bfhi(b.z) + bf2f(f2bf(h1[2])) * bflo(b.w) + bf2f(f2bf(h1[3])) * bfhi(b.w); }
        s = wave_sum(s); ss = wave_sum(ss);
        if (F.lane == 0) pmeta[o] = s / sqrtf(ss * (1.f / DM) + EPS); }
}
__device__ __forceinline__ void p7_conv_glu(const Frame& F, const Args& a) {
    bf16* proj = (bf16*)(a.ws + WS_PROJ); const bf16* halo = (const bf16*)(a.ws + WS_HALO); const float* pmeta = (const float*)(a.ws + WS_PMETA);
    const float* cw = a.in[IN_FCW]; const float* cb = a.in[IN_FCB];
    constexpr int CG = DFF / 8;
    const int NT = F.G * NWAVES * 64;
    for (int it = (F.vcu * NWAVES + F.wave) * 64 + F.lane; it < 256 * CG; it += NT) {
        const int rb = it / CG, c0 = (it % CG) * 8;
        const int vcol = (c0 < 1024) ? c0 : c0 + 3840;
        float wg[3][8], wv[3][8], bg[8], bv[8], g2[8], g1[8], v2[8], v1[8];
#pragma unroll
        for (int k = 0; k < 3; ++k)
#pragma unroll
            for (int j = 0; j < 8; ++j) { wg[k][j] = cw[k * NUP + c0 + j]; wv[k][j] = cw[k * NUP + DFF + c0 + j]; }
#pragma unroll
        for (int j = 0; j < 8; ++j) { bg[j] = cb[c0 + j]; bv[j] = cb[DFF + c0 + j]; }
        if ((rb & 63) == 0) {
#pragma unroll
            for (int j = 0; j < 8; ++j) { g2[j] = pmeta[c0 + j]; v2[j] = pmeta[DFF + c0 + j]; g1[j] = pmeta[NUP + c0 + j]; v1[j] = pmeta[NUP + DFF + c0 + j]; }
        } else {
            const bf16* h = halo + (size_t)((rb - 1) * 2) * NUP;
            const v4u a0 = *(const v4u*)(h + c0), a1 = *(const v4u*)(h + DFF + c0), b0 = *(const v4u*)(h + NUP + c0), b1 = *(const v4u*)(h + NUP + DFF + c0);
            g2[0] = bflo(a0.x); g2[1] = bfhi(a0.x); g2[2] = bflo(a0.y); g2[3] = bfhi(a0.y); g2[4] = bflo(a0.z); g2[5] = bfhi(a0.z); g2[6] = bflo(a0.w); g2[7] = bfhi(a0.w);
            v2[0] = bflo(a1.x); v2[1] = bfhi(a1.x); v2[2] = bflo(a1.y); v2[3] = bfhi(a1.y); v2[4] = bflo(a1.z); v2[5] = bfhi(a1.z); v2[6] = bflo(a1.w); v2[7] = bfhi(a1.w);
            g1[0] = bflo(b0.x); g1[1] = bfhi(b0.x); g1[2] = bflo(b0.y); g1[3] = bfhi(b0.y); g1[4] = bflo(b0.z); g1[5] = bfhi(b0.z); g1[6] = bflo(b0.w); g1[7] = bfhi(b0.w);
            v1[0] = bflo(b1.x); v1[1] = bfhi(b1.x); v1[2] = bflo(b1.y); v1[3] = bfhi(b1.y); v1[4] = bflo(b1.z); v1[5] = bfhi(b1.z); v1[6] = bflo(b1.w); v1[7] = bfhi(b1.w);
        }
        bf16* rowp = proj + (size_t)(rb * 64) * LDP;
#pragma unroll 2
        for (int r = 0; r < 64; ++r, rowp += LDP) {
            const v4u pg = *(const v4u*)(rowp + 2048 + c0), pv = *(const v4u*)(rowp + vcol);
            float g0[8], v0[8], o[8];
            g0[0] = bflo(pg.x); g0[1] = bfhi(pg.x); g0[2] = bflo(pg.y); g0[3] = bfhi(pg.y); g0[4] = bflo(pg.z); g0[5] = bfhi(pg.z); g0[6] = bflo(pg.w); g0[7] = bfhi(pg.w);
            v0[0] = bflo(pv.x); v0[1] = bfhi(pv.x); v0[2] = bflo(pv.y); v0[3] = bfhi(pv.y); v0[4] = bflo(pv.z); v0[5] = bfhi(pv.z); v0[6] = bflo(pv.w); v0[7] = bfhi(pv.w);
#pragma unroll
            for (int j = 0; j < 8; ++j) { const float ug = bg[j] + wg[0][j] * g2[j] + wg[1][j] * g1[j] + wg[2][j] * g0[j]; const float uv = bv[j] + wv[0][j] * v2[j] + wv[1][j] * v1[j] + wv[2][j] * v0[j];
                o[j] = siluf_(ug) * uv; g2[j] = g1[j]; g1[j] = g0[j]; v2[j] = v1[j]; v1[j] = v0[j]; }
            v4u w; w.x = pk2(o[0], o[1]); w.y = pk2(o[2], o[3]); w.z = pk2(o[4], o[5]); w.w = pk2(o[6], o[7]);
            *(v4u*)(rowp + 2048 + c0) = w;
        }
    }
}
__device__ __forceinline__ void p9_final_norm(const Frame& F, const Args& a) {
    const int gw = F.vcu * NWAVES + F.wave, NGW = F.G * NWAVES;
    const float* rss = (const float*)(a.ws + WS_SSQ); const f32x4* wv = (const f32x4*)a.in[IN_FNW] + F.lane;
    for (int m = gw; m < MREAL; m += NGW) {
        const f32x4* rp = (const f32x4*)(rss + (size_t)m * 16); const f32x4 sa = rp[0], sb = rp[1], sc_ = rp[2], sd = rp[3];
        const float tot = (((sa[0] + sa[1]) + (sa[2] + sa[3])) + ((sb[0] + sb[1]) + (sb[2] + sb[3]))) + (((sc_[0] + sc_[1]) + (sc_[2] + sc_[3])) + ((sd[0] + sd[1]) + (sd[2] + sd[3])));
        const float rs = 1.f / sqrtf(tot * (1.f / DM) + EPS);
        f32x4* o = (f32x4*)(a.out + (size_t)m * DM) + F.lane;
#pragma unroll
        for (int j = 0; j < 4; ++j) { const f32x4 v = o[64 * j], w = wv[64 * j]; o[64 * j] = v * rs * w; }
    }
}

namespace mix {
constexpr int QP = 136, TP = 72;
constexpr int L_QD = 0, L_KI = 17408, L_KET = 34816, L_VT = 53248, L_VET = 71680, L_XT = 90112, L_SC = 108544, L_SM = 126976;
constexpr size_t DO_HGU = 0, DO_MBU = 16 * MiB, DO_HGD = 32 * MiB, DO_MBD = 33 * MiB;
typedef unsigned long long u64;
typedef float f32x2 __attribute__((ext_vector_type(2)));
typedef short bf16x4 __attribute__((ext_vector_type(4)));
#define MFMA16(a, b, c) __builtin_amdgcn_mfma_f32_16x16x32_bf16((a), (b), (c), 0, 0, 0)

__device__ __forceinline__ size_t seq_row(int b, int p) { return p < NMETA ? (size_t)(MREAL + p) : (size_t)b * SEQ + (p - NMETA); }
__device__ __forceinline__ unsigned row_off(int b, int p) { return (unsigned)(p < NMETA ? (MREAL + p) : b * SEQ + (p - NMETA)) * (unsigned)(LDP * 2); }
__device__ __forceinline__ float ldbf(const unsigned char* base, unsigned off) { return bf2f(*(const bf16*)(base + off)); }
__device__ __forceinline__ v4u pack8f(const float* x) { v4u w; w.x = pk2(x[0], x[1]); w.y = pk2(x[2], x[3]); w.z = pk2(x[4], x[5]); w.w = pk2(x[6], x[7]); return w; }
__device__ __forceinline__ bf16x8 ld_frag16(const LAS unsigned char* p) { return *(const LAS bf16x8*)p; }
__device__ __forceinline__ bf16x8 ld_frag8x2(const LAS unsigned char* p0, const LAS unsigned char* p1) {
    const bf16x4 a = *(const LAS bf16x4*)p0, b = *(const LAS bf16x4*)p1; return __builtin_shufflevector(a, b, 0, 1, 2, 3, 4, 5, 6, 7); }
__device__ __forceinline__ bf16x8 pack_state(const f32x4 a, const f32x4 b) {
    v4u w; w.x = pk2(a[0], a[1]); w.y = pk2(a[2], a[3]); w.z = pk2(b[0], b[1]); w.w = pk2(b[2], b[3]); return __builtin_bit_cast(bf16x8, w); }

template <bool OUT>
__device__ __forceinline__ void hgrn2_item(LAS unsigned char* L, const Args& a, int bh, int j, int tid, int wave, int lane) {
    const int b = bh >> 3, h = bh & 7;
    const int k = tid & 127, seg = tid >> 7, n = lane & 15, g = lane >> 4;
    bf16* proj = (bf16*)(a.ws + WS_PROJ); bf16* mixmeta = (bf16*)(a.ws + WS_MIXMETA); const unsigned char* pb = a.ws + WS_PROJ;
    float* HGU = (float*)((unsigned char*)a.out + DO_HGU); float* HGD = (float*)((unsigned char*)a.out + DO_HGD);
    LAS float* segtot = (LAS float*)(L + L_SM); LAS float* dvec = (LAS float*)(L + L_SM + 2048); LAS float* emid = (LAS float*)(L + L_SM + 2560);
    LAS float* red = (LAS float*)(L + L_VET); LAS float* rinv = (LAS float*)(L + L_VET + 2048);
    const float nw = OUT ? a.in[IN_HGNW][h * 128 + wave * 16 + n] : 0.f;
    f32x4 S[8];
#pragma unroll
    for (int kt = 0; kt < 8; ++kt) S[kt] = (f32x4){0.f, 0.f, 0.f, 0.f};
    if (OUT) {
        for (int i = 0; i < j; ++i) { const float* U = HGU + ((size_t)(bh * 7 + i)) * 16384 + (size_t)(wave * 8 * 64 + lane) * 4; const float* D = HGD + (size_t)(bh * 7 + i) * 128 + 4 * g;
#pragma unroll
            for (int kt = 0; kt < 8; ++kt) { const f32x4 d4 = *(const f32x4*)(D + kt * 16), u4 = *(const f32x4*)(U + kt * 256); S[kt] = S[kt] * d4 + u4; } }
    }
    float bsum = 0.f;
    const int c0 = j == 0 ? 0 : 8 * j + 1, c1 = 8 * j + 8;
    for (int c = c0; c <= c1; ++c) {
        const int p0 = c * 64 + seg * 16 - 48;
        float lf[16], kk[16], qv[16], vv[16];
#pragma unroll
        for (int i = 0; i < 16; ++i) { const int p = p0 + i;
            const bool ok = p >= 0; const unsigned ro = row_off(b, ok ? p : 0) + (unsigned)(h * 128 + k) * 2u;
            const float fp = ldbf(pb, ro + F0 * 2), iv = ldbf(pb, ro + I0 * 2), qp = OUT ? ldbf(pb, ro + Q0 * 2) : 0.f;
            lf[i] = ok ? fp : 0.f; kk[i] = ok ? 1.f - __expf(fp) : 0.f; vv[i] = ok ? iv : 0.f; qv[i] = ok ? qp : 0.f; }
        float run = 0.f;
#pragma unroll
        for (int i = 0; i < 16; ++i) { run += lf[i]; lf[i] = run; }
        segtot[seg * 128 + k] = run;
        __syncthreads();
        const float t0 = segtot[k], t1 = segtot[128 + k], t2 = segtot[256 + k], t3 = segtot[384 + k];
        const float off = seg == 0 ? 0.f : (seg == 1 ? t0 : (seg == 2 ? t0 + t1 : (t0 + t1) + t2));
        const float bmid = t0 + t1, blast = (t0 + t1) + (t2 + t3);
        float ke[16];
#pragma unroll
        for (int i = 0; i < 16; ++i) { const float bc = off + lf[i];
            if (OUT) { ((LAS bf16*)(L + L_QD))[(16 * seg + i) * QP + k] = (bf16)f2bf(qv[i] * __expf(bc - bmid)); ((LAS bf16*)(L + L_KI))[(16 * seg + i) * QP + k] = (bf16)f2bf(kk[i] * __expf(bmid - bc)); }
            ke[i] = kk[i] * __expf(blast - bc); }
        *(LAS v4u*)(L + L_KET + (k * TP + 16 * seg) * 2) = pack8f(ke); *(LAS v4u*)(L + L_KET + (k * TP + 16 * seg + 8) * 2) = pack8f(ke + 8);
        *(LAS v4u*)(L + L_VT + (k * TP + 16 * seg) * 2) = pack8f(vv); *(LAS v4u*)(L + L_VT + (k * TP + 16 * seg + 8) * 2) = pack8f(vv + 8);
        if (seg == 0) { dvec[k] = __expf(blast); emid[k] = __expf(bmid); bsum += blast; }
        __syncthreads();
        float gv[4][4];
        if (OUT) {
#pragma unroll
            for (int tt = 0; tt < 4; ++tt)
#pragma unroll
                for (int r = 0; r < 4; ++r) { const int p = c * 64 + tt * 16 + 4 * g + r - 48; gv[tt][r] = ldbf(pb, row_off(b, p >= 0 ? p : 0) + (unsigned)(G0 + h * 128 + wave * 16 + n) * 2u); }
        }
        bf16x8 vf[2];
#pragma unroll
        for (int ss = 0; ss < 2; ++ss) vf[ss] = ld_frag16(L + L_VT + ((wave * 16 + n) * TP + ss * 32 + 8 * g) * 2);
        f32x4 O[4];
        if (OUT) {
            const int ti = wave >> 1;
#pragma unroll
            for (int q = 0; q < 2; ++q) { const int si = 2 * (wave & 1) + q; f32x4 acc = (f32x4){0.f, 0.f, 0.f, 0.f};
                if (si <= ti) {
#pragma unroll
                    for (int ks = 0; ks < 4; ++ks) acc = MFMA16(ld_frag16(L + L_QD + ((ti * 16 + n) * QP + ks * 32 + 8 * g) * 2), ld_frag16(L + L_KI + ((si * 16 + n) * QP + ks * 32 + 8 * g) * 2), acc); }
#pragma unroll
                for (int r = 0; r < 4; ++r) { const int t = ti * 16 + 4 * g + r, s_ = si * 16 + n; ((LAS bf16*)(L + L_SC))[t * TP + s_] = (bf16)f2bf(t >= s_ ? acc[r] : 0.f); } }
            __syncthreads();
#pragma unroll
            for (int tt = 0; tt < 4; ++tt) { O[tt] = (f32x4){0.f, 0.f, 0.f, 0.f};
#pragma unroll
                for (int ss = 0; ss < 2; ++ss) if (ss * 32 <= tt * 16 + 15) O[tt] = MFMA16(ld_frag16(L + L_SC + ((tt * 16 + n) * TP + ss * 32 + 8 * g) * 2), vf[ss], O[tt]); }
            bf16x8 sb[4];
#pragma unroll
            for (int ks = 0; ks < 4; ++ks) { const f32x4 e0 = *(const LAS f32x4*)(emid + (2 * ks) * 16 + 4 * g), e1 = *(const LAS f32x4*)(emid + (2 * ks + 1) * 16 + 4 * g); sb[ks] = pack_state(S[2 * ks] * e0, S[2 * ks + 1] * e1); }
#pragma unroll
            for (int tt = 0; tt < 4; ++tt)
#pragma unroll
                for (int ks = 0; ks < 4; ++ks) { const LAS unsigned char* qp = L + L_QD + ((tt * 16 + n) * QP + ks * 32 + 4 * g) * 2; O[tt] = MFMA16(ld_frag8x2(qp, qp + 32), sb[ks], O[tt]); }
        }
#pragma unroll
        for (int kt = 0; kt < 8; ++kt) { const f32x4 d4 = *(const LAS f32x4*)(dvec + kt * 16 + 4 * g); S[kt] = S[kt] * d4;
#pragma unroll
            for (int ts = 0; ts < 2; ++ts) S[kt] = MFMA16(ld_frag16(L + L_KET + ((kt * 16 + n) * TP + ts * 32 + 8 * g) * 2), vf[ts], S[kt]); }
        if (OUT) {
#pragma unroll
            for (int tt = 0; tt < 4; ++tt)
#pragma unroll
                for (int r = 0; r < 4; ++r) { float ss = O[tt][r] * O[tt][r]; ss += __shfl_xor(ss, 1); ss += __shfl_xor(ss, 2); ss += __shfl_xor(ss, 4); ss += __shfl_xor(ss, 8); if (n == 0) red[wave * 64 + tt * 16 + 4 * g + r] = ss; }
            __syncthreads();
            if (tid < 64) { float tot = 0.f;
#pragma unroll
                for (int w = 0; w < 8; ++w) tot += red[w * 64 + tid];
                rinv[tid] = 1.f / sqrtf(tot * (1.f / 128.f) + EPS); }
            __syncthreads();
#pragma unroll
            for (int tt = 0; tt < 4; ++tt) { const f32x4 ri = *(const LAS f32x4*)(rinv + tt * 16 + 4 * g);
#pragma unroll
                for (int r = 0; r < 4; ++r) { const int p = c * 64 + tt * 16 + 4 * g + r - 48; const bf16 o = (bf16)f2bf(O[tt][r] * ri[r] * nw * gv[tt][r]);
                    if (p >= NMETA) proj[seq_row(b, p) * LDP + Q0 + h * 128 + wave * 16 + n] = o;
                    else if (p >= 0 && b == 0) mixmeta[(size_t)p * 2048 + h * 128 + wave * 16 + n] = o; } }
        } else {
            __syncthreads();
        }
    }
    if (!OUT) {
        float* U = HGU + ((size_t)(bh * 7 + j)) * 16384 + (size_t)(wave * 8 * 64 + lane) * 4;
#pragma unroll
        for (int kt = 0; kt < 8; ++kt) *(f32x4*)(U + kt * 256) = S[kt];
        if (seg == 0) HGD[(size_t)(bh * 7 + j) * 128 + k] = __expf(bsum);
    }
}

template <bool OUT>
__device__ __forceinline__ void mamba_item(LAS unsigned char* L, const Args& a, int bp, int j, int tid, int wave, int lane) {
    const int b = bp >> 3, pair = bp & 7, grp = pair >> 2, hm0 = 2 * pair;
    const int c_ = tid & 127, seg = tid >> 7, hd = c_ >> 6, n = lane & 15, g = lane >> 4, whd = wave >> 2;
    bf16* proj = (bf16*)(a.ws + WS_PROJ); bf16* mixmeta = (bf16*)(a.ws + WS_MIXMETA); float* ssq = (float*)(a.ws + WS_SSQ); const unsigned char* pb = a.ws + WS_PROJ;
    float* MBU = (float*)((unsigned char*)a.out + DO_MBU); float* MBD = (float*)((unsigned char*)a.out + DO_MBD);
    LAS float* acum = (LAS float*)(L + L_SM); LAS float* eac = (LAS float*)(L + L_SM + 512); LAS float* misc = (LAS float*)(L + L_SM + 1024);
    LAS float* red = (LAS float*)(L + L_SM + 2048);
    const float* cw = a.in[IN_CW]; const float* cb = a.in[IN_CB];
    const int colx = hm0 * 64 + c_, colb = 1024 + grp * 128 + c_, colc = 1280 + grp * 128 + c_;
    const float Ah = -__expf(a.in[IN_ALOG][hm0 + hd]);
    f32x4 S[8];
#pragma unroll
    for (int kt = 0; kt < 8; ++kt) S[kt] = (f32x4){0.f, 0.f, 0.f, 0.f};
    if (OUT) {
        for (int i = 0; i < j; ++i) { const float* U = MBU + ((size_t)(bp * 7 + i)) * 16384 + (size_t)(wave * 8 * 64 + lane) * 4; const float d = MBD[(size_t)(bp * 7 + i) * 2 + whd];
#pragma unroll
            for (int kt = 0; kt < 8; ++kt) { const f32x4 u4 = *(const f32x4*)(U + kt * 256); S[kt] = S[kt] * d + u4; } }
    }
    float asum = 0.f;
    const int c0 = j == 0 ? 0 : 8 * j + 1, c1 = 8 * j + 8;
    for (int c = c0; c <= c1; ++c) {
        const int p0 = c * 64 + seg * 16 - 48;
#define MB_RO(i) (row_off(b, (p0 - 3 + (i)) >= 0 ? (p0 - 3 + (i)) : 0) + XBC0 * 2)
#define MB_OK(i) (p0 - 3 + (i) >= 0)
        {
            float rb[19], Bs[16]; float wb[4];
#pragma unroll
            for (int q = 0; q < 4; ++q) wb[q] = cw[q * 1536 + colb];
            const float bb = cb[colb];
#pragma unroll
            for (int i = 0; i < 19; ++i) { const float t_ = ldbf(pb, MB_RO(i) + (unsigned)colb * 2u); rb[i] = MB_OK(i) ? t_ : 0.f; }
#pragma unroll
            for (int i = 0; i < 16; ++i) { Bs[i] = siluf_(bb + wb[0] * rb[i] + wb[1] * rb[i + 1] + wb[2] * rb[i + 2] + wb[3] * rb[i + 3]);
                if (OUT) ((LAS bf16*)(L + L_KI))[(16 * seg + i) * QP + c_] = (bf16)f2bf(Bs[i]); }
            *(LAS v4u*)(L + L_KET + (c_ * TP + 16 * seg) * 2) = pack8f(Bs); *(LAS v4u*)(L + L_KET + (c_ * TP + 16 * seg + 8) * 2) = pack8f(Bs + 8);
        }
        if (OUT) {
            float rc[19]; float wc[4];
#pragma unroll
            for (int q = 0; q < 4; ++q) wc[q] = cw[q * 1536 + colc];
            const float bc_ = cb[colc];
#pragma unroll
            for (int i = 0; i < 19; ++i) { const float t_ = ldbf(pb, MB_RO(i) + (unsigned)colc * 2u); rc[i] = MB_OK(i) ? t_ : 0.f; }
#pragma unroll
            for (int i = 0; i < 16; ++i) ((LAS bf16*)(L + L_QD))[(16 * seg + i) * QP + c_] = (bf16)f2bf(siluf_(bc_ + wc[0] * rc[i] + wc[1] * rc[i + 1] + wc[2] * rc[i + 2] + wc[3] * rc[i + 3]));
        }
        float vv[16], pre[16];
        float run = 0.f;
        {
            float rx[19], xs[16]; float wx[4];
#pragma unroll
            for (int q = 0; q < 4; ++q) wx[q] = cw[q * 1536 + colx];
            const float bx = cb[colx];
#pragma unroll
            for (int i = 0; i < 19; ++i) { const float t_ = ldbf(pb, MB_RO(i) + (unsigned)colx * 2u); rx[i] = MB_OK(i) ? t_ : 0.f; }
#pragma unroll
            for (int i = 0; i < 16; ++i) { const float dtr = ldbf(pb, MB_RO(i + 3) + (unsigned)(DT0 - XBC0 + hm0 + hd) * 2u); const float dt = MB_OK(i + 3) ? dtr : 0.f;
                xs[i] = siluf_(bx + wx[0] * rx[i] + wx[1] * rx[i + 1] + wx[2] * rx[i + 2] + wx[3] * rx[i + 3]);
                vv[i] = xs[i] * dt; run += dt * Ah; pre[i] = run; }
            if (OUT) { *(LAS v4u*)(L + L_XT + (c_ * TP + 16 * seg) * 2) = pack8f(xs); *(LAS v4u*)(L + L_XT + (c_ * TP + 16 * seg + 8) * 2) = pack8f(xs + 8);
                *(LAS v4u*)(L + L_VT + (c_ * TP + 16 * seg) * 2) = pack8f(vv); *(LAS v4u*)(L + L_VT + (c_ * TP + 16 * seg + 8) * 2) = pack8f(vv + 8); }
        }
#undef MB_RO
#undef MB_OK
        if ((c_ & 63) == 0) misc[8 + 4 * hd + seg] = run;
        __syncthreads();
        const float t0 = misc[8 + 4 * hd], t1 = misc[9 + 4 * hd], t2 = misc[10 + 4 * hd], t3 = misc[11 + 4 * hd];
        const float off = seg == 0 ? 0.f : (seg == 1 ? t0 : (seg == 2 ? t0 + t1 : (t0 + t1) + t2));
        const float alast = (t0 + t1) + (t2 + t3);
        float ve[16];
#pragma unroll
        for (int i = 0; i < 16; ++i) { const float ac = off + pre[i]; ve[i] = vv[i] * __expf(alast - ac);
            if (OUT) { if ((c_ & 63) == 0) { acum[hd * 64 + 16 * seg + i] = ac; eac[hd * 64 + 16 * seg + i] = __expf(ac); } } }
        *(LAS v4u*)(L + L_VET + (c_ * TP + 16 * seg) * 2) = pack8f(ve); *(LAS v4u*)(L + L_VET + (c_ * TP + 16 * seg + 8) * 2) = pack8f(ve + 8);
        if ((c_ & 63) == 0 && seg == 0) { misc[hd] = __expf(alast); asum += alast; }
        __syncthreads();
        float zv[4][4];
        if (OUT) {
#pragma unroll
            for (int tt = 0; tt < 4; ++tt)
#pragma unroll
                for (int r = 0; r < 4; ++r) { const int p = c * 64 + tt * 16 + 4 * g + r - 48; zv[tt][r] = ldbf(pb, row_off(b, p >= 0 ? p : 0) + (unsigned)(Z0 + hm0 * 64 + wave * 16 + n) * 2u); }
        }
        bf16x8 vef[2];
#pragma unroll
        for (int ss = 0; ss < 2; ++ss) vef[ss] = ld_frag16(L + L_VET + ((wave * 16 + n) * TP + ss * 32 + 8 * g) * 2);
        f32x4 O[4];
        if (OUT) {
            const int ti = wave >> 1;
#pragma unroll
            for (int q = 0; q < 2; ++q) { const int si = 2 * (wave & 1) + q; f32x4 acc = (f32x4){0.f, 0.f, 0.f, 0.f};
                if (si <= ti) {
#pragma unroll
                    for (int ks = 0; ks < 4; ++ks) acc = MFMA16(ld_frag16(L + L_QD + ((ti * 16 + n) * QP + ks * 32 + 8 * g) * 2), ld_frag16(L + L_KI + ((si * 16 + n) * QP + ks * 32 + 8 * g) * 2), acc); }
#pragma unroll
                for (int h2 = 0; h2 < 2; ++h2) { const f32x4 at = *(const LAS f32x4*)(acum + h2 * 64 + ti * 16 + 4 * g); const float as = acum[h2 * 64 + si * 16 + n];
#pragma unroll
                    for (int r = 0; r < 4; ++r) { const int t = ti * 16 + 4 * g + r, s_ = si * 16 + n; ((LAS bf16*)(L + L_SC))[(h2 * 64 + t) * TP + s_] = (bf16)f2bf(t >= s_ ? acc[r] * __expf(at[r] - as) : 0.f); } } }
            __syncthreads();
            bf16x8 vf[2];
#pragma unroll
            for (int ss = 0; ss < 2; ++ss) vf[ss] = ld_frag16(L + L_VT + ((wave * 16 + n) * TP + ss * 32 + 8 * g) * 2);
            f32x4 O2[4];
#pragma unroll
            for (int tt = 0; tt < 4; ++tt) { O[tt] = (f32x4){0.f, 0.f, 0.f, 0.f}; O2[tt] = (f32x4){0.f, 0.f, 0.f, 0.f};
#pragma unroll
                for (int ss = 0; ss < 2; ++ss) if (ss * 32 <= tt * 16 + 15) O[tt] = MFMA16(ld_frag16(L + L_SC + ((whd * 64 + tt * 16 + n) * TP + ss * 32 + 8 * g) * 2), vf[ss], O[tt]); }
            bf16x8 sb[4];
#pragma unroll
            for (int ks = 0; ks < 4; ++ks) sb[ks] = pack_state(S[2 * ks], S[2 * ks + 1]);
#pragma unroll
            for (int tt = 0; tt < 4; ++tt)
#pragma unroll
                for (int ks = 0; ks < 4; ++ks) { const LAS unsigned char* qp = L + L_QD + ((tt * 16 + n) * QP + ks * 32 + 4 * g) * 2; O2[tt] = MFMA16(ld_frag8x2(qp, qp + 32), sb[ks], O2[tt]); }
#pragma unroll
            for (int tt = 0; tt < 4; ++tt) { const f32x4 ea = *(const LAS f32x4*)(eac + whd * 64 + tt * 16 + 4 * g); O[tt] = O[tt] + ea * O2[tt]; }
        }
        { const float el = misc[whd];
#pragma unroll
          for (int kt = 0; kt < 8; ++kt) { S[kt] = S[kt] * el;
#pragma unroll
            for (int ts = 0; ts < 2; ++ts) S[kt] = MFMA16(ld_frag16(L + L_KET + ((kt * 16 + n) * TP + ts * 32 + 8 * g) * 2), vef[ts], S[kt]); } }
        if (OUT) {
            float y[4][4];
            const float Dw = a.in[IN_D][hm0 + whd], nw = a.in[IN_M2NW][hm0 * 64 + wave * 16 + n];
#pragma unroll
            for (int tt = 0; tt < 4; ++tt) {
                const u64 xw = *(const LAS u64*)(L + L_XT + ((wave * 16 + n) * TP + tt * 16 + 4 * g) * 2);
                const float x0 = bflo((unsigned)xw), x1 = bfhi((unsigned)xw), x2 = bflo((unsigned)(xw >> 32)), x3 = bfhi((unsigned)(xw >> 32));
                y[tt][0] = (O[tt][0] + Dw * x0) * zv[tt][0]; y[tt][1] = (O[tt][1] + Dw * x1) * zv[tt][1];
                y[tt][2] = (O[tt][2] + Dw * x2) * zv[tt][2]; y[tt][3] = (O[tt][3] + Dw * x3) * zv[tt][3];
#pragma unroll
                for (int r = 0; r < 4; ++r) { float ss = y[tt][r] * y[tt][r]; ss += __shfl_xor(ss, 1); ss += __shfl_xor(ss, 2); ss += __shfl_xor(ss, 4); ss += __shfl_xor(ss, 8); if (n == 0) red[wave * 64 + tt * 16 + 4 * g + r] = ss; } }
            __syncthreads();
            if (tid < 128) { const int h2 = tid >> 6, t = tid & 63; const float tot = (red[(4 * h2) * 64 + t] + red[(4 * h2 + 1) * 64 + t]) + (red[(4 * h2 + 2) * 64 + t] + red[(4 * h2 + 3) * 64 + t]);
                const int p = c * 64 + t - 48; if (p >= NMETA || (p >= 0 && b == 0)) ssq[seq_row(b, p) * 16 + hm0 + h2] = tot; }
#pragma unroll
            for (int tt = 0; tt < 4; ++tt)
#pragma unroll
                for (int r = 0; r < 4; ++r) { const int p = c * 64 + tt * 16 + 4 * g + r - 48; const bf16 o = (bf16)f2bf(y[tt][r] * nw);
                    if (p >= NMETA) proj[seq_row(b, p) * LDP + Z0 + hm0 * 64 + wave * 16 + n] = o;
                    else if (p >= 0 && b == 0) mixmeta[(size_t)p * 2048 + 1024 + hm0 * 64 + wave * 16 + n] = o; }
        } else {
            __syncthreads();
        }
    }
    if (!OUT) {
        float* U = MBU + ((size_t)(bp * 7 + j)) * 16384 + (size_t)(wave * 8 * 64 + lane) * 4;
#pragma unroll
        for (int kt = 0; kt < 8; ++kt) *(f32x4*)(U + kt * 256) = S[kt];
        if ((c_ & 63) == 0 && seg == 0) MBD[(size_t)(bp * 7 + j) * 2 + hd] = __expf(asum);
    }
}
#undef MFMA16
}
__global__ void __launch_bounds__(NWAVES * 64, 2) mk_fwd(Args args) {
    extern __shared__ __attribute__((aligned(16))) unsigned char lds[];
    Frame F;
    F.lds = (LAS unsigned char*)lds;
    F.tid = threadIdx.x; F.lane = F.tid & 63; F.wave = __builtin_amdgcn_readfirstlane(F.tid >> 6);
    F.G = gridDim.x; { const int bx = blockIdx.x; F.vcu = (F.G % 8 == 0) ? (bx % 8) * (F.G / 8) + bx / 8 : bx; }
    volatile LAS unsigned* MISC = (volatile LAS unsigned*)(F.lds + MISC_OFF);
    unsigned char* ws = args.ws;
    for (int u = F.tid; u < (LDS_BYTES - LDSCTL_OFF) / 4; u += NWAVES * 64) ((LAS unsigned*)(F.lds + LDSCTL_OFF))[u] = 0u;
    __syncthreads();
    const int lo = args.ph_lo, hi = args.ph_hi;
    const bool use_bar = (hi - lo) > 1;
    XcdBarrier bar; bar.bar = (unsigned*)(ws + WS_CTL) + CW_BAR; bar.x = 0; bar.st = nullptr;
    if (use_bar) bar = xcd_barrier_post((unsigned*)(ws + WS_CTL) + CW_BAR, MISC + 8);
#define IN(k) (lo <= (k) && (k) < hi)
#define SEAM(k) do { if (IN(k) && IN((k) + 1)) xcd_barrier(bar); } while (0)
    bf16* proj = (bf16*)(ws + WS_PROJ);

#define PRB_BEGIN(k) do { if (MK_PROBE_LO == (k) && blockIdx.x == 0 && F.tid == 0) *(volatile LAS unsigned long long*)(MISC + 16) = __builtin_amdgcn_s_memrealtime(); } while (0)
#define PRB_END(k) do { if (MK_PROBE_HI == (k) && blockIdx.x == 0 && F.tid == 0) *(volatile LAS unsigned long long*)(MISC + 18) = __builtin_amdgcn_s_memrealtime(); } while (0)
    PRB_BEGIN(0);
    if (IN(0)) { p0_prologue(F, args); SEAM(0); }
    PRB_END(0); PRB_BEGIN(1);
    if (IN(1)) {
        pg8::Gemm g{(const bf16*)((unsigned char*)args.out + DO_U), (const bf16*)((unsigned char*)args.out + DO_WTIN), M1, LDP, DM, DM, 1 << 30, 0};
        pg8::StaticOrder S; S.init(M1, LDP, F.G, (int)blockIdx.x);
        pg8::EpiProj E{proj, LDP, args.in[IN_LBL], args.in[IN_DTB]};
        pg8::gemm_phase<pg8::EpiProj, pg8::StaticOrder, true, true>(F.lds + RING_OFF, g, S, E);
        SEAM(1);
    }
    PRB_END(1); PRB_BEGIN(2);
    if (IN(2)) {
        for (int it = F.vcu; it < 448; it += F.G) {
            if (it < 224) { mix::hgrn2_item<false>(F.lds + RING_OFF, args, it / 7, it % 7, F.tid, F.wave, F.lane); }
            else { mix::mamba_item<false>(F.lds + RING_OFF, args, (it - 224) / 7, (it - 224) % 7, F.tid, F.wave, F.lane); }
        }
        SEAM(2);
    }
    PRB_END(2); PRB_BEGIN(3);
    if (IN(3)) {
        for (int it = F.vcu; it < 256; it += F.G) { mix::hgrn2_item<true>(F.lds + RING_OFF, args, it >> 3, it & 7, F.tid, F.wave, F.lane); __syncthreads(); }
        for (int it = F.vcu; it < 256; it += F.G) { mix::mamba_item<true>(F.lds + RING_OFF, args, it >> 3, 7 - (it & 7), F.tid, F.wave, F.lane); __syncthreads(); }
        SEAM(3);
    }
    PRB_END(3); PRB_BEGIN(4);
    if (IN(4)) { p4_groupnorm(F, args); SEAM(4); }
    PRB_END(4); PRB_BEGIN(5);
    if (IN(5)) {
        p5_meta_tail(F, args); VM_WAIT(); __syncthreads();
        pg8::Gemm g{proj, (const bf16*)(ws + WS_WTOUT), MREAL, DM, 2048, LDP, 16, (Z0 - 1024) * 2};
        pg8::StaticOrder S; S.init(MREAL, DM, F.G, (int)blockIdx.x);
        pg8::EpiResid<true> E{args.in[IN_X], args.out, proj + F0, LDP, (float*)(ws + WS_RSS)};
        pg8::gemm_phase<pg8::EpiResid<true>, pg8::StaticOrder, false, true>(F.lds + RING_OFF, g, S, E);
        SEAM(5);
    }
    PRB_END(5); PRB_BEGIN(6);
    if (IN(6)) {
        p6_meta_tail(F, args); VM_WAIT(); __syncthreads();
        pg8::Gemm g{proj + F0, (const bf16*)(ws + WS_WTUP), MREAL, NUP, DM, LDP, 1 << 30, 0};
        pg8::StaticOrder S; S.init(MREAL, NUP, F.G, (int)blockIdx.x);
        pg8::EpiUp E{proj, (const float*)(ws + WS_RSS), (bf16*)(ws + WS_HALO)};
        pg8::gemm_phase<pg8::EpiUp, pg8::StaticOrder, true, true>(F.lds + RING_OFF, g, S, E);
        SEAM(6);
    }
    PRB_END(6); PRB_BEGIN(7);
    if (IN(7)) { p7_conv_glu(F, args); SEAM(7); }
    PRB_END(7); PRB_BEGIN(8);
    if (IN(8)) {
        pg8::Gemm g{proj + 2048, (const bf16*)(ws + WS_WTDN), MREAL, DM, DFF, LDP, 1 << 30, 0};
        pg8::StaticOrder S; S.init(MREAL, DM, F.G, (int)blockIdx.x);
        pg8::EpiResid<false> E{args.out, args.out, nullptr, 0, (float*)(ws + WS_SSQ)};
        pg8::gemm_phase<pg8::EpiResid<false>, pg8::StaticOrder, false, true>(F.lds + RING_OFF, g, S, E);
        SEAM(8);
    }
    PRB_END(8); PRB_BEGIN(9);
    if (IN(9)) { p9_final_norm(F, args); }
    PRB_END(9);
    if (MK_PROBE_LO >= 0 && blockIdx.x == 0 && F.tid == 0) { const unsigned long long want = (unsigned long long)MK_PROBE_MULT * (*(volatile LAS unsigned long long*)(MISC + 18) - *(volatile LAS unsigned long long*)(MISC + 16)), t0 = __builtin_amdgcn_s_memrealtime();
        while (__builtin_amdgcn_s_memrealtime() - t0 < want) __builtin_amdgcn_s_sleep(8); }
#undef PRB_BEGIN
#undef PRB_END
#undef IN
#undef SEAM
}

extern "C" void kernel_launch(void* const* d_in, const int* in_sizes, int n_in, void* d_out, int out_size, void* d_ws, size_t ws_size, hipStream_t stream) {
    static int grid = 0;
    if (grid == 0) {
        if (n_in != 19 || in_sizes[0] != MREAL * DM || out_size != MREAL * DM || ws_size < WS_END) { fprintf(stderr, "kernel_launch: unexpected shapes (n_in %d, in0 %d, out %d, ws %zu); nothing launched\n", n_in, n_in > 0 ? in_sizes[0] : -1, out_size, ws_size); grid = -1; return; }
        int dev = 0, cus = 0;
        if (hipGetDevice(&dev) != hipSuccess || hipDeviceGetAttribute(&cus, hipDeviceAttributeMultiprocessorCount, dev) != hipSuccess) { grid = -1; return; }
        if (hipFuncSetAttribute((const void*)mk_fwd, hipFuncAttributeMaxDynamicSharedMemorySize, LDS_BYTES) != hipSuccess) { fprintf(stderr, "kernel_launch: hipFuncSetAttribute failed\n"); grid = -1; return; }
        (void)hipGetLastError();
        grid = cus;
    }
    if (grid < 0) return;
    if (hipMemsetAsync((char*)d_ws + WS_CTL, 0, CTL_ZERO_BYTES, stream) != hipSuccess) { fprintf(stderr, "kernel_launch: memset failed\n"); return; }
    Args a{};
    for (int i = 0; i < 19; ++i) a.in[i] = (const float*)d_in[i];
    a.out = (float*)d_out; a.ws = (unsigned char*)d_ws;
#if MK_PER_PHASE
    const int phases[] = {0, 1, 2, 3, 4, 5, 6, 7, 8, 9};
    for (int ph : phases) {
        a.ph_lo = ph; a.ph_hi = ph + 1;
        hipLaunchKernelGGL(mk_fwd, dim3(grid), dim3(NWAVES * 64), LDS_BYTES, stream, a);
    }
#else
    a.ph_lo = 0; a.ph_hi = 10;
    hipLaunchKernelGGL(mk_fwd, dim3(grid), dim3(NWAVES * 64), LDS_BYTES, stream, a);
#endif
    const hipError_t le = hipPeekAtLastError();
    if (le != hipSuccess) fprintf(stderr, "kernel_launch: launch failed: %s\n", hipGetErrorName(le));
}
```

```cpp
#include <hip/hip_runtime.h>
#include <cstdio>
#include <cstdint>

#ifndef MK_PER_PHASE
#define MK_PER_PHASE 0
#endif
#ifndef MK_PROBE_LO
#define MK_PROBE_LO (-1)
#define MK_PROBE_HI (-1)
#endif
#ifndef MK_PROBE_MULT
#define MK_PROBE_MULT 4
#endif

namespace pg8 {
#define PG8_LAS __attribute__((address_space(3)))
typedef unsigned short bf16_t;
typedef short bf16x8 __attribute__((ext_vector_type(8)));
typedef float f32x4 __attribute__((ext_vector_type(4)));
typedef unsigned u32x4 __attribute__((ext_vector_type(4)));
constexpr int BM = 256, BK = 64, HALF = 128, HTB = HALF * BK * 2  , STAGE_BYTES = 8 * HTB, NXCD = 8, WGM = 8;

__host__ __device__ __forceinline__ int lds_byte(int r, int c) { const int st = (r >> 4) * 2 + (c >> 5), rr = r & 15, cc = c & 31, ob = rr * 64 + cc * 2; return st * 1024 + (ob ^ (((ob >> 9) & 1) << 5)); }
__host__ __device__ __forceinline__ void stage_rc(int b, int& R, int& C) { const int st = b / 1024, sb = b % 1024, swz = sb ^ (((sb >> 9) & 1) << 5); R = (st >> 1) * 16 + swz / 64; C = (st & 1) * 32 + (swz % 64) / 2; }
__host__ __device__ __forceinline__ int perm32(int rho) { const int n = rho >> 4, i = rho & 15; return 8 * (i >> 2) + 4 * n + (i & 3); }

struct Unit { int pm, pn; };
struct Gemm { const bf16_t* A; const bf16_t* Bt; int M, N, K; int lda; int ksplit; int kjump; };

struct StaticOrder {
    int nM, nN, nwg, G, c;
    __host__ __device__ void init(int M, int N, int G_, int c_) { nM = M / BM; nN = N / BM; nwg = nM * nN; G = G_; c = c_; }
    __host__ __device__ bool next(int i, Unit& u) const {
        const long L = (long)i * G + c; if (L >= nwg) return false;
        int wgid = (int)L; { const int q = nwg / NXCD, r = nwg % NXCD, xcd = wgid % NXCD, off = wgid / NXCD; wgid = (xcd < r ? xcd * (q + 1) : r * (q + 1) + (xcd - r) * q) + off; }
        const int nig = WGM * nN, gid = wgid / nig, fm = gid * WGM, gsz = (nM - fm) < WGM ? (nM - fm) : WGM;
        u.pm = fm + ((wgid % nig) % gsz); u.pn = (wgid % nig) / gsz; return true;
    }
    __device__ __forceinline__ void a_ready(const Unit&) const {}
    __device__ __forceinline__ void done(const Unit&) const {}
};

__device__ __forceinline__ unsigned cvt_pk_bf16(float lo, float hi) { unsigned r; asm volatile("v_cvt_pk_bf16_f32 %0, %1, %2" : "=v"(r) : "v"(lo), "v"(hi)); return r; }
__device__ __forceinline__ u32x4 pack8(const f32x4 v0, const f32x4 v1) { u32x4 w; w.x = cvt_pk_bf16(v0[0], v0[1]); w.y = cvt_pk_bf16(v0[2], v0[3]); w.z = cvt_pk_bf16(v1[0], v1[1]); w.w = cvt_pk_bf16(v1[2], v1[3]); return w; }

__device__ __forceinline__ float ep_silu(float x) { return x * __builtin_amdgcn_rcpf(1.0f + __expf(-x)); }
struct EpiProj {
    static constexpr bool PERM = true, AFTER_DRAIN = false;
    bf16_t* O; int ldc; const float* lbl; const float* dtb; bf16_t* xhalo;
    __device__ __forceinline__ void operator()(const f32x4 (&acc)[2][2][4][2], const Unit& u, int wr, int wc, int fr, int fq) const {
        const int row0 = u.pm * BM + wr * 64 + fr, col0 = u.pn * BM + wc * 32 + 8 * fq;
        const int kind = (u.pn < 4) ? 1 : (u.pn < 8 ? 2 : (u.pn < 12 ? 0 : (u.pn < 20 ? 1 : (u.pn == 26 ? 3 : 0))));
        float par[2][8];
        if (kind == 2) {
#pragma unroll
            for (int bj = 0; bj < 2; ++bj)
#pragma unroll
                for (int j = 0; j < 8; ++j) { const int c = col0 + bj * HALF + j - 1024; par[bj][j] = __builtin_amdgcn_rcpf(1.0f + __expf(lbl[1024 + c] - lbl[c])); }
        } else if (kind == 3) {
#pragma unroll
            for (int bj = 0; bj < 2; ++bj)
#pragma unroll
                for (int j = 0; j < 8; ++j) { const int c = col0 + bj * HALF + j - 6656; par[bj][j] = (c >= 0 && c < 16) ? dtb[c] : 0.f; }
        }
#pragma unroll
        for (int ai = 0; ai < 2; ++ai)
#pragma unroll
            for (int m = 0; m < 4; ++m) { const int row = row0 + ai * HALF + m * 16; bf16_t* rowp = O + (size_t)row * ldc + col0;
                int hslot = -1; if (u.pn >= 20 && u.pn < 26) { if (row < 16384) { if ((row & 63) >= 61) hslot = (row >> 6) * 3 + (row & 63) - 61; } else if (row >= 16397 && row < 16400) hslot = 256 * 3 + row - 16397; }
#pragma unroll
                for (int bj = 0; bj < 2; ++bj) { f32x4 v0 = acc[ai][bj][m][0], v1 = acc[ai][bj][m][1];
                    if (hslot >= 0) *(u32x4*)(xhalo + (size_t)hslot * 1536 + (col0 + bj * HALF - 5120)) = pack8(v0, v1);
                    if (kind == 1) {
#pragma unroll
                        for (int j = 0; j < 4; ++j) { v0[j] = ep_silu(v0[j]); v1[j] = ep_silu(v1[j]); }
                    } else if (kind == 2) {
#pragma unroll
                        for (int j = 0; j < 4; ++j) { const float l0 = par[bj][j], l1 = par[bj][4 + j];
                            v0[j] = __logf(l0 + (1.0f - l0) * __builtin_amdgcn_rcpf(1.0f + __expf(-v0[j]))); v1[j] = __logf(l1 + (1.0f - l1) * __builtin_amdgcn_rcpf(1.0f + __expf(-v1[j]))); }
                    } else if (kind == 3) {
#pragma unroll
                        for (int j = 0; j < 4; ++j) { const float x0 = v0[j] + par[bj][j], x1 = v1[j] + par[bj][4 + j]; const float u0 = __expf(x0), u1 = __expf(x1);
                            const float s0 = u0 * (1.0f - u0 * (0.5f - u0 * (0.33333334f - u0 * 0.25f))), s1 = u1 * (1.0f - u1 * (0.5f - u1 * (0.33333334f - u1 * 0.25f)));
                            v0[j] = x0 > 20.f ? x0 : (u0 < 0.0625f ? s0 : __logf(1.0f + u0)); v1[j] = x1 > 20.f ? x1 : (u1 < 0.0625f ? s1 : __logf(1.0f + u1)); }
                    }
                    *(u32x4*)(rowp + bj * HALF) = pack8(v0, v1); } }
    }
};
template <bool WRITE_A2> struct EpiResid {
    static constexpr bool PERM = true, AFTER_DRAIN = false;
    const float* base; float* out; bf16_t* a2; int lda2; float* rss;
    __device__ __forceinline__ void operator()(const f32x4 (&acc)[2][2][4][2], const Unit& u, int wr, int wc, int fr, int fq) const {
        const int row0 = u.pm * BM + wr * 64 + fr, col0 = u.pn * BM + wc * 32 + 8 * fq;
#pragma unroll
        for (int ai = 0; ai < 2; ++ai)
#pragma unroll
            for (int m = 0; m < 4; ++m) { const int row = row0 + ai * HALF + m * 16; float ss = 0.f;
#pragma unroll
                for (int bj = 0; bj < 2; ++bj) { const size_t o = (size_t)row * 1024 + col0 + bj * HALF;
                    const f32x4 v0 = acc[ai][bj][m][0] + *(const f32x4*)(base + o), v1 = acc[ai][bj][m][1] + *(const f32x4*)(base + o + 4);
                    *(f32x4*)(out + o) = v0; *(f32x4*)(out + o + 4) = v1;
                    ss += (v0[0] * v0[0] + v0[1] * v0[1]) + (v0[2] * v0[2] + v0[3] * v0[3]) + (v1[0] * v1[0] + v1[1] * v1[1]) + (v1[2] * v1[2] + v1[3] * v1[3]);
                    if (WRITE_A2) *(u32x4*)(a2 + (size_t)row * lda2 + col0 + bj * HALF) = pack8(v0, v1); }
                ss += __shfl_xor(ss, 16); ss += __shfl_xor(ss, 32);
                if (fq == 0) rss[(size_t)row * 16 + u.pn * 4 + wc] = ss; }
    }
};
struct EpiUp {
    static constexpr bool PERM = true, AFTER_DRAIN = false;
    bf16_t* proj; const float* rss; bf16_t* halo;
    __device__ __forceinline__ void operator()(const f32x4 (&acc)[2][2][4][2], const Unit& u, int wr, int wc, int fr, int fq) const {
        const int row0 = u.pm * BM + wr * 64 + fr, jc = u.pn * 128 + wc * 32 + 8 * fq;
        const int dcol[2] = { 2048 + jc, (u.pn < 8) ? jc : jc + 3840 };
#pragma unroll
        for (int ai = 0; ai < 2; ++ai)
#pragma unroll
            for (int m = 0; m < 4; ++m) { const int row = row0 + ai * HALF + m * 16;
                const f32x4* rp = (const f32x4*)(rss + (size_t)row * 16); const f32x4 a = rp[0], b = rp[1], c = rp[2], d = rp[3];
                const float tot = (((a[0] + a[1]) + (a[2] + a[3])) + ((b[0] + b[1]) + (b[2] + b[3]))) + (((c[0] + c[1]) + (c[2] + c[3])) + ((d[0] + d[1]) + (d[2] + d[3])));
                const float rs = 1.0f / sqrtf(tot * (1.0f / 1024.0f) + 1e-6f);
#pragma unroll
                for (int bj = 0; bj < 2; ++bj) { const u32x4 w = pack8(acc[ai][bj][m][0] * rs, acc[ai][bj][m][1] * rs);
                    *(u32x4*)(proj + (size_t)row * 6912 + dcol[bj]) = w;
                    if ((row & 63) >= 62) *(u32x4*)(halo + (size_t)((row >> 6) * 2 + (row & 1)) * 5632 + bj * 2816 + jc) = w; } }
    }
};

template <class Epi, class Sched, bool ALIGN_EPI = false, bool SP2 = false>
__device__ __forceinline__ void gemm_phase(PG8_LAS unsigned char* lds, const Gemm g, const Sched& S, const Epi& E) {
    const int tid = threadIdx.x, wid = __builtin_amdgcn_readfirstlane(tid >> 6), lane = tid & 63, wr = wid >> 2, wc = wid & 3, fr = lane & 15, fq = lane >> 4;
    const int K = g.K, nt = K / BK, lda = g.lda;
    unsigned voffA[2], voffB[2];
#pragma unroll
    for (int i = 0; i < 2; ++i) { int R, C; stage_rc(tid * 16 + i * 8192, R, C); const int Rb = Epi::PERM ? ((R & ~31) + perm32(R & 31)) : R;
        voffA[i] = (unsigned)(R * lda + C) * 2u; voffB[i] = (unsigned)(Rb * K + C) * 2u; }
    const size_t kstep = (size_t)(BK * 2);
    const size_t hstepA = (size_t)HALF * lda * 2, tstepA = 2 * hstepA;
    const size_t hstepB = (size_t)HALF * K * 2, tstepB = 2 * hstepB;
    const int ksplit = g.ksplit; const size_t kjump = (size_t)g.kjump;
#define PG8_AK(kt) ((size_t)(kt) * kstep + (((kt) >= ksplit) ? kjump : (size_t)0))
    const unsigned ldsw = (unsigned)wid * 1024u;
    const int aoff = lds_byte(wr * 64 + fr, fq * 8), boff = lds_byte(wc * 32 + fr, fq * 8);
#define PG8_SA(b, h) (((b) * 2 + (h)) * HTB)
#define PG8_SB(b, h) ((4 + (b) * 2 + (h)) * HTB)
#define PG8_STAGE(bufoff, gbase, voff) do { _Pragma("unroll") for (int _i = 0; _i < 2; ++_i) \
        __builtin_amdgcn_global_load_lds((const unsigned*)((const char*)(gbase) + (voff)[_i]), (PG8_LAS unsigned*)(lds + (bufoff) + ldsw + _i * 8192), 16, 0, 0); } while (0)
#define PG8_LDA(dst, b, h) do { _Pragma("unroll") for (int m = 0; m < 4; ++m) _Pragma("unroll") for (int k = 0; k < 2; ++k) dst[m][k] = *(const PG8_LAS bf16x8*)(lds + PG8_SA(b, h) + aoff + m * 2048 + k * 1024); } while (0)
#define PG8_LDB(dst, b, h) do { _Pragma("unroll") for (int n = 0; n < 2; ++n) _Pragma("unroll") for (int k = 0; k < 2; ++k) dst[n][k] = *(const PG8_LAS bf16x8*)(lds + PG8_SB(b, h) + boff + n * 2048 + k * 1024); } while (0)
#define PG8_MMA(ai, bj, At, Bt) do { __builtin_amdgcn_s_setprio(1); _Pragma("unroll") for (int m = 0; m < 4; ++m) _Pragma("unroll") for (int n = 0; n < 2; ++n) _Pragma("unroll") for (int k = 0; k < 2; ++k) \
        acc[ai][bj][m][n] = __builtin_amdgcn_mfma_f32_16x16x32_bf16(Bt[n][k], At[m][k], acc[ai][bj][m][n], 0, 0, 0); __builtin_amdgcn_s_setprio(0); } while (0)
#define PG8_WAIT_V(n) asm volatile("s_waitcnt vmcnt(" #n ")" ::: "memory")
#define PG8_WAIT_L(n) asm volatile("s_waitcnt lgkmcnt(" #n ")" ::: "memory")
#define PG8_BAR __builtin_amdgcn_s_barrier()
#define PG8_SCHED __builtin_amdgcn_sched_barrier(0)
    Unit cur, nxt; int ui = 0;
    if (!S.next(0, cur)) return;
    f32x4 acc[2][2][4][2];
#pragma unroll
    for (int a = 0; a < 2; ++a)
#pragma unroll
        for (int b = 0; b < 2; ++b)
#pragma unroll
            for (int m = 0; m < 4; ++m)
#pragma unroll
                for (int n = 0; n < 2; ++n) acc[a][b][m][n] = (f32x4){0.f, 0.f, 0.f, 0.f};
    bf16x8 At[4][2], B0[2][2], B1[2][2];
    const char* cA = (const char*)g.A + (size_t)cur.pm * tstepA; const char* cB = (const char*)g.Bt + (size_t)cur.pn * tstepB;
    S.a_ready(cur);
    if constexpr (SP2) {
        PG8_STAGE(PG8_SB(0, 0), cB, voffB); PG8_STAGE(PG8_SB(0, 1), cB + hstepB, voffB); PG8_STAGE(PG8_SA(0, 0), cA, voffA); PG8_STAGE(PG8_SA(0, 1), cA + hstepA, voffA);
        if (wr == 1) PG8_BAR;
        PG8_WAIT_V(2); PG8_BAR;
        PG8_STAGE(PG8_SB(1, 0), cB + kstep, voffB); PG8_STAGE(PG8_SA(1, 0), cA + PG8_AK(1), voffA); PG8_STAGE(PG8_SB(1, 1), cB + hstepB + kstep, voffB);
        PG8_WAIT_V(6); PG8_BAR;
    } else {
        PG8_STAGE(PG8_SB(0, 0), cB, voffB); PG8_STAGE(PG8_SA(0, 0), cA, voffA); PG8_STAGE(PG8_SB(0, 1), cB + hstepB, voffB); PG8_STAGE(PG8_SA(0, 1), cA + hstepA, voffA);
        if (wr == 1) PG8_BAR;
        PG8_WAIT_V(4); PG8_BAR;
        PG8_STAGE(PG8_SB(1, 0), cB + kstep, voffB); PG8_STAGE(PG8_SA(1, 0), cA + PG8_AK(1), voffA); PG8_STAGE(PG8_SB(1, 1), cB + hstepB + kstep, voffB);
        PG8_WAIT_V(6); PG8_BAR;
    }
    for (;;) {
        const bool has_next = S.next(ui + 1, nxt);
        const char* nA = has_next ? (const char*)g.A + (size_t)nxt.pm * tstepA : cA; const char* nB = has_next ? (const char*)g.Bt + (size_t)nxt.pn * tstepB : cB;
        for (int t = 0; t < nt; t += 2) {
            const bool last = (t == nt - 2);
            const char* a1 = cA + PG8_AK(t + 1);
            const char* a2 = last ? nA : cA + PG8_AK(t + 2); const char* b2 = last ? nB : cB + (size_t)(t + 2) * kstep;
            const char* a3 = last ? nA + PG8_AK(1) : cA + PG8_AK(t + 3); const char* b3 = b2 + kstep;
            if (last && has_next) S.a_ready(nxt);
            if constexpr (SP2) {
            PG8_LDB(B0, 0, 0); PG8_LDB(B1, 0, 1); PG8_SCHED; PG8_LDA(At, 0, 0); PG8_STAGE(PG8_SA(1, 1), a1 + hstepA, voffA);
            PG8_WAIT_V(8); PG8_WAIT_L(0); PG8_BAR; PG8_MMA(0, 0, At, B0); PG8_MMA(0, 1, At, B1); PG8_BAR; PG8_SCHED;
            PG8_LDA(At, 0, 1); PG8_STAGE(PG8_SB(0, 0), b2, voffB); PG8_STAGE(PG8_SB(0, 1), b2 + hstepB, voffB); PG8_STAGE(PG8_SA(0, 0), a2, voffA);
            PG8_WAIT_V(8); PG8_WAIT_L(0); PG8_BAR; PG8_MMA(1, 0, At, B0); PG8_MMA(1, 1, At, B1); PG8_BAR; PG8_SCHED;
            PG8_LDB(B0, 1, 0); PG8_LDB(B1, 1, 1); PG8_SCHED; PG8_LDA(At, 1, 0); PG8_STAGE(PG8_SA(0, 1), a2 + hstepA, voffA);
            PG8_WAIT_V(8); PG8_WAIT_L(0); PG8_BAR; PG8_MMA(0, 0, At, B0); PG8_MMA(0, 1, At, B1); PG8_BAR; PG8_SCHED;
            PG8_LDA(At, 1, 1); PG8_STAGE(PG8_SB(1, 0), b3, voffB); PG8_STAGE(PG8_SB(1, 1), b3 + hstepB, voffB); PG8_STAGE(PG8_SA(1, 0), a3, voffA);
            PG8_WAIT_V(8); PG8_WAIT_L(0); PG8_BAR; PG8_MMA(1, 0, At, B0); PG8_MMA(1, 1, At, B1); PG8_BAR; PG8_SCHED;
            } else {
            PG8_LDB(B0, 0, 0); PG8_SCHED; PG8_LDA(At, 0, 0); PG8_STAGE(PG8_SA(1, 1), a1 + hstepA, voffA);
            PG8_WAIT_L(8); PG8_BAR; PG8_WAIT_L(0); PG8_MMA(0, 0, At, B0); PG8_BAR; PG8_SCHED;
            PG8_LDB(B1, 0, 1); PG8_STAGE(PG8_SB(0, 0), b2, voffB);
            PG8_BAR; PG8_WAIT_L(0); PG8_MMA(0, 1, At, B1); PG8_BAR;
            PG8_LDA(At, 0, 1); PG8_STAGE(PG8_SA(0, 0), a2, voffA);
            PG8_BAR; PG8_WAIT_L(0); PG8_MMA(1, 0, At, B0); PG8_BAR; PG8_SCHED;
            PG8_STAGE(PG8_SB(0, 1), b2 + hstepB, voffB);
            PG8_WAIT_V(6); PG8_BAR; PG8_MMA(1, 1, At, B1); PG8_BAR;
            PG8_LDB(B0, 1, 0); PG8_SCHED; PG8_LDA(At, 1, 0); PG8_STAGE(PG8_SA(0, 1), a2 + hstepA, voffA);
            PG8_WAIT_L(8); PG8_BAR; PG8_WAIT_L(0); PG8_MMA(0, 0, At, B0); PG8_BAR; PG8_SCHED;
            PG8_LDB(B1, 1, 1); PG8_STAGE(PG8_SB(1, 0), b3, voffB);
            PG8_BAR; PG8_WAIT_L(0); PG8_MMA(0, 1, At, B1); PG8_BAR;
            PG8_LDA(At, 1, 1); PG8_STAGE(PG8_SA(1, 0), a3, voffA);
            PG8_BAR; PG8_WAIT_L(0); PG8_MMA(1, 0, At, B0); PG8_BAR; PG8_SCHED;
            PG8_STAGE(PG8_SB(1, 1), b3 + hstepB, voffB);
            PG8_WAIT_V(6); PG8_BAR; PG8_MMA(1, 1, At, B1); PG8_BAR;
            }
        }
        if constexpr (ALIGN_EPI) { if (wr == 0) PG8_BAR; }
        if constexpr (!Epi::AFTER_DRAIN) { E(acc, cur, wr, wc, fr, fq); S.done(cur); }
        if (!has_next) break;
#pragma unroll
        for (int a = 0; a < 2; ++a)
#pragma unroll
            for (int b = 0; b < 2; ++b)
#pragma unroll
                for (int m = 0; m < 4; ++m)
#pragma unroll
                    for (int n = 0; n < 2; ++n) acc[a][b][m][n] = (f32x4){0.f, 0.f, 0.f, 0.f};
        cur = nxt; cA = nA; cB = nB; ++ui;
        if constexpr (ALIGN_EPI) { if (wr == 1) PG8_BAR; }
    }
    PG8_WAIT_V(0);
    if constexpr (!ALIGN_EPI) { if (wr == 0) PG8_BAR; }
    PG8_BAR;
#undef PG8_AK
#undef PG8_SA
#undef PG8_SB
#undef PG8_STAGE
#undef PG8_LDA
#undef PG8_LDB
#undef PG8_MMA
#undef PG8_WAIT_V
#undef PG8_WAIT_L
#undef PG8_BAR
#undef PG8_SCHED
}
}

constexpr int NWAVES = 8;
constexpr int NB = 4, SEQ = 4096, DM = 1024, NMETA = 16;
constexpr int MREAL = NB * SEQ;
constexpr int MROWS = MREAL + NMETA;
constexpr int M1 = 16640;
constexpr int NPROJ = 6672, LDP = 6912;
constexpr int Q0 = 0, F0 = 1024, I0 = 2048, G0 = 3072, Z0 = 4096, XBC0 = 5120, DT0 = 6656;
constexpr int DFF = 2816, NUP = 2 * DFF;
constexpr float EPS = 1e-6f;

constexpr size_t MiB = 1u << 20;
constexpr size_t WS_CTL = 0, CTL_ZERO_BYTES = 1 * MiB;
constexpr size_t WS_WTOUT = 1 * MiB;
constexpr size_t WS_WTUP = 5 * MiB;
constexpr size_t WS_WTDN = 16 * MiB;
constexpr size_t WS_SSQ = 22 * MiB;
constexpr size_t WS_RSS = 23 * MiB + 512 * 1024;
constexpr size_t WS_MIXMETA = 24 * MiB + 512 * 1024;
constexpr size_t WS_H2M = WS_MIXMETA + 64 * 1024;
constexpr size_t WS_PMETA = WS_H2M + 16 * 1024;
constexpr size_t WS_HALO = 25 * MiB;
constexpr size_t WS_PROJ = 31 * MiB;
constexpr size_t WS_END = WS_PROJ + (size_t)M1 * LDP * 2;
static_assert(WS_END <= 256 * MiB, "d_ws map");
constexpr size_t DO_U = 0, DO_WTIN = 34 * MiB;
static_assert(DO_WTIN + (size_t)LDP * DM * 2 <= 64 * MiB && (size_t)M1 * DM * 2 <= DO_WTIN, "d_out scratch map");
constexpr int CW_BAR = 4096;

constexpr int RING_OFF = 0, RING_BYTES = 131072;
constexpr int LDSCTL_OFF = RING_BYTES, MISC_OFF = LDSCTL_OFF + 320;
constexpr int LDS_BYTES = 147456;

#define GAS __attribute__((address_space(1)))
#define LAS __attribute__((address_space(3)))
typedef unsigned short bf16;
typedef unsigned v4u __attribute__((ext_vector_type(4)));
typedef float f32x4 __attribute__((ext_vector_type(4)));
typedef short bf16x8 __attribute__((ext_vector_type(8)));
typedef GAS unsigned gu32;
#define RLX_AGENT __ATOMIC_RELAXED, __HIP_MEMORY_SCOPE_AGENT
#define LDS_WAIT() asm volatile("s_waitcnt lgkmcnt(0)" ::: "memory")
#define VM_WAIT() asm volatile("s_waitcnt vmcnt(0)" ::: "memory")
__device__ __forceinline__ unsigned f2bf(float f) { unsigned u = __builtin_bit_cast(unsigned, f); return (u + 0x7fffu + ((u >> 16) & 1u)) >> 16; }
typedef float f32x2_t_ __attribute__((ext_vector_type(2)));
typedef __bf16 bf16x2_t_ __attribute__((ext_vector_type(2)));
__device__ __forceinline__ unsigned pk2(float lo, float hi) { const f32x2_t_ v = {lo, hi}; const bf16x2_t_ b = __builtin_convertvector(v, bf16x2_t_); return __builtin_bit_cast(unsigned, b); }
__device__ __forceinline__ float bf2f(unsigned short b) { return __builtin_bit_cast(float, ((unsigned)b) << 16); }
__device__ __forceinline__ float bflo(unsigned w) { return __builtin_bit_cast(float, w << 16); }
__device__ __forceinline__ float bfhi(unsigned w) { return __builtin_bit_cast(float, w & 0xffff0000u); }
__device__ __forceinline__ float sigmoidf_(float x) { return __builtin_amdgcn_rcpf(1.0f + __expf(-x)); }
__device__ __forceinline__ float siluf_(float x) { return x * __builtin_amdgcn_rcpf(1.0f + __expf(-x)); }
__device__ __forceinline__ float softplusf_(float x) { const float u = __expf(x); const float ser = u * (1.0f - u * (0.5f - u * (0.33333334f - u * 0.25f))); return x > 20.f ? x : (u < 0.0625f ? ser : __logf(1.0f + u)); }

#define XB_TMO      128
#define XB_XCNT(j)  (256  + 64 * (j))
#define XB_XSUB(j)  (1280 + 64 * (j))
#define XB_XGEN(j)  (2304 + 64 * (j))
#define XB_TOP      3328
#define XB_TOPGEN   3392
#define XCD_BAR_WORDS 3456
#define XB_SPIN_CAP (1u << 18)
__device__ __forceinline__ unsigned xb_ld(unsigned* p)              { return __hip_atomic_load(p, __ATOMIC_RELAXED, __HIP_MEMORY_SCOPE_AGENT); }
__device__ __forceinline__ unsigned xb_add(unsigned* p, unsigned v) { return __hip_atomic_fetch_add(p, v, __ATOMIC_RELAXED, __HIP_MEMORY_SCOPE_AGENT); }
__device__ __forceinline__ unsigned xb_xcc_id() { return (unsigned)__builtin_amdgcn_s_getreg((3 << 11) | 20) & 0xFu; }
#define XB_SPIN(cond, bar) do { unsigned _sp = 0; while (cond) { __builtin_amdgcn_s_sleep(1); \
    if ((++_sp & 255u) == 0u) { if (xb_ld(&(bar)[XB_TMO])) break; if (_sp > XB_SPIN_CAP) { atomicAdd(&(bar)[XB_TMO], 1u); break; } } } } while (0)
struct XcdBarrier { unsigned* bar; unsigned x; volatile LAS unsigned* st; };
__device__ __forceinline__ XcdBarrier xcd_barrier_post(unsigned* bar, volatile LAS unsigned* st) {
    XcdBarrier b; b.bar = bar; b.x = xb_xcc_id(); b.st = st;
    if (threadIdx.x == 0) (void)xb_add(&bar[XB_XCNT(b.x)], 1u);
    return b;
}
__device__ __forceinline__ void xcd_barrier_complete(unsigned* bar, unsigned x, unsigned& nloc, unsigned& nx) {
    const unsigned G = gridDim.x * gridDim.y * gridDim.z;
    unsigned sum, cnt, mine, sp = 0u;
    for (;;) {
        sum = 0u; cnt = 0u; mine = 0u;
#pragma unroll
        for (unsigned j = 0; j < 16; ++j) { const unsigned c = xb_ld(&bar[XB_XCNT(j)]); sum += c; cnt += (c > 0u) ? 1u : 0u; mine = (j == x) ? c : mine; }
        if (sum == G) break;
        __builtin_amdgcn_s_sleep(1);
        if ((++sp & 255u) == 0u) { if (xb_ld(&bar[XB_TMO])) break; if (sp > XB_SPIN_CAP) { atomicAdd(&bar[XB_TMO], 1u); break; } }
    }
    nloc = mine > 0u ? mine : 1u; nx = cnt > 0u ? cnt : 1u;
}
__device__ __forceinline__ void xcd_barrier(const XcdBarrier& b) {
    asm volatile("s_waitcnt vmcnt(0)" ::: "memory");
    __syncthreads();
    if (threadIdx.x == 0) {
        unsigned* bar = b.bar;
        __builtin_amdgcn_s_waitcnt(0);
        unsigned nloc = b.st[0], nx = b.st[1];
        if (nloc == 0u) { xcd_barrier_complete(bar, b.x, nloc, nx); b.st[0] = nloc; b.st[1] = nx; }
        const unsigned old = xb_add(&bar[XB_XSUB(b.x)], 1u);
        const unsigned gen = old / nloc;
        if (old + 1u == (gen + 1u) * nloc) {
            __builtin_amdgcn_fence(__ATOMIC_RELEASE, "agent");
            asm volatile("s_waitcnt vmcnt(0)" ::: "memory");
            const unsigned og = xb_add(&bar[XB_TOP], 1u);
            const unsigned tg = og / nx;
            if (og + 1u == (tg + 1u) * nx) xb_add(&bar[XB_TOPGEN], 1u);
            else XB_SPIN(xb_ld(&bar[XB_TOPGEN]) == tg, bar);
            __builtin_amdgcn_fence(__ATOMIC_ACQUIRE, "agent");
            xb_add(&bar[XB_XGEN(b.x)], 1u);
            asm volatile("s_waitcnt vmcnt(0)" ::: "memory");
        } else {
            XB_SPIN(xb_ld(&bar[XB_XGEN(b.x)]) == gen, bar);
            __builtin_amdgcn_fence(__ATOMIC_ACQUIRE, "agent");
            asm volatile("s_waitcnt vmcnt(0)" ::: "memory");
        }
    }
    __syncthreads();
}

struct Args { const float* in[19]; float* out; unsigned char* ws; int ph_lo, ph_hi; };
enum { IN_X = 0, IN_META, IN_N1W, IN_WIN, IN_LBL, IN_HGNW, IN_CW, IN_CB, IN_DTB, IN_ALOG, IN_D, IN_M2NW, IN_WOUT, IN_N2W, IN_WUP, IN_FCW, IN_FCB, IN_WDN, IN_FNW };

struct Frame {
    LAS unsigned char* lds;
    int tid, lane, wave, vcu, G;
};

__device__ __forceinline__ float wave_sum(float v) {
#pragma unroll
    for (int o = 1; o < 64; o <<= 1) v += __shfl_xor(v, o);
    return v;
}

__device__ __forceinline__ void p0_transpose_item(const float* W, int K, int N, int nvalid, bf16* WT, int drow0, int scol0, int k0, const float* kscale, LAS float* scr, int lane) {
    const int c = scol0 + (lane & 31);
#pragma unroll 8
    for (int i = 0; i < 32; ++i) { const int kk = 2 * i + (lane >> 5); float v = (c < nvalid) ? W[(size_t)(k0 + kk) * N + c] : 0.f; if (kscale) v *= kscale[k0 + kk]; scr[kk * 33 + (lane & 31)] = v; }
    LDS_WAIT(); asm volatile("" ::: "memory");
    const int ch = lane & 7;
#pragma unroll
    for (int j = 0; j < 4; ++j) { const int n = (lane >> 3) + 8 * j; const LAS float* s = scr + (8 * ch) * 33 + n;
        v4u o; o.x = pk2(s[0 * 33], s[1 * 33]); o.y = pk2(s[2 * 33], s[3 * 33]); o.z = pk2(s[4 * 33], s[5 * 33]); o.w = pk2(s[6 * 33], s[7 * 33]);
        *(GAS v4u*)(WT + (size_t)(drow0 + n) * K + k0 + 8 * ch) = o; }
    LDS_WAIT(); asm volatile("" ::: "memory");
}
__device__ __forceinline__ void rms_row_to_bf16(int lane, const float* xrow, const float* w, bf16* orow) {
    GAS unsigned long long* o8 = (GAS unsigned long long*)orow + lane;
    if (xrow == nullptr) {
#pragma unroll
        for (int j = 0; j < 4; ++j) o8[64 * j] = 0ull;
        return; }
    const GAS f32x4* xr = (const GAS f32x4*)xrow + lane; const GAS f32x4* wr = (const GAS f32x4*)w + lane;
    f32x4 v[4]; float s = 0.f;
#pragma unroll
    for (int j = 0; j < 4; ++j) { v[j] = xr[64 * j]; s += (v[j].x * v[j].x + v[j].y * v[j].y) + (v[j].z * v[j].z + v[j].w * v[j].w); }
    const float rs = 1.f / sqrtf(wave_sum(s) * (1.f / DM) + EPS);
#pragma unroll
    for (int j = 0; j < 4; ++j) { const f32x4 ww = wr[64 * j]; o8[64 * j] = (unsigned long long)pk2(v[j].x * rs * ww.x, v[j].y * rs * ww.y) | ((unsigned long long)pk2(v[j].z * rs * ww.z, v[j].w * rs * ww.w) << 32); }
}

__device__ __forceinline__ void p0_prologue(const Frame& F, const Args& a) {
    LAS float* scr = (LAS float*)(F.lds + RING_OFF + F.wave * 16384);
    const int gw = F.vcu * NWAVES + F.wave, NGW = F.G * NWAVES;
    bf16* WTin = (bf16*)((unsigned char*)a.out + DO_WTIN); bf16* WTout = (bf16*)(a.ws + WS_WTOUT); bf16* WTup = (bf16*)(a.ws + WS_WTUP); bf16* WTdn = (bf16*)(a.ws + WS_WTDN);
    constexpr int I_IN = (LDP / 32) * (DM / 64), I_OUT = (DM / 32) * (2048 / 64), I_UP = (NUP / 32) * (DM / 64), I_DN = (DM / 32) * (DFF / 64);
    constexpr int NITEMS = I_IN + I_OUT + I_UP + I_DN;
    for (int it = gw; it < NITEMS; it += NGW) {
        int r = it;
        if (r < I_IN) { const int nb = r % (LDP / 32), kb = r / (LDP / 32); p0_transpose_item(a.in[IN_WIN], DM, NPROJ, NPROJ, WTin, nb * 32, nb * 32, kb * 64, nullptr, scr, F.lane); continue; } r -= I_IN;
        if (r < I_OUT) { const int nb = r % (DM / 32), kb = r / (DM / 32); p0_transpose_item(a.in[IN_WOUT], 2048, DM, DM, WTout, nb * 32, nb * 32, kb * 64, nullptr, scr, F.lane); continue; } r -= I_OUT;
        if (r < I_UP) { const int nb = r % (NUP / 32), kb = r / (NUP / 32); const int d0 = nb * 32, pn = d0 >> 8, rem = d0 & 255, bj = rem >> 7, j = rem & 127;
            p0_transpose_item(a.in[IN_WUP], DM, NUP, NUP, WTup, d0, bj * DFF + pn * 128 + j, kb * 64, a.in[IN_N2W], scr, F.lane); continue; } r -= I_UP;
        { const int nb = r % (DM / 32), kb = r / (DM / 32); p0_transpose_item(a.in[IN_WDN], DFF, DM, DM, WTdn, nb * 32, nb * 32, kb * 64, nullptr, scr, F.lane); }
    }
    bf16* U = (bf16*)((unsigned char*)a.out + DO_U);
    for (int m = gw; m < M1; m += NGW) {
        const float* src = (m < MREAL) ? a.in[IN_X] + (size_t)m * DM : (m < MROWS ? a.in[IN_META] + (size_t)(m - MREAL) * DM : nullptr);
        rms_row_to_bf16(F.lane, src, a.in[IN_N1W], U + (size_t)m * DM);
    }
}

__device__ __forceinline__ void p4_groupnorm(const Frame& F, const Args& a) {
    const int gw = F.vcu * NWAVES + F.wave, NGW = F.G * NWAVES;
    bf16* proj = (bf16*)(a.ws + WS_PROJ); bf16* mixmeta = (bf16*)(a.ws + WS_MIXMETA); const float* ssq = (const float*)(a.ws + WS_SSQ);
    for (int m = gw; m < MROWS; m += NGW) {
        bf16* p = (m < MREAL) ? proj + (size_t)m * LDP + Z0 : mixmeta + (size_t)(m - MREAL) * 2048 + 1024;
        const int g = F.lane >> 5; const f32x4* sp = (const f32x4*)(ssq + (size_t)m * 16 + g * 8); const f32x4 s0 = sp[0], s1 = sp[1];
        const float tot = ((s0[0] + s0[1]) + (s0[2] + s0[3])) + ((s1[0] + s1[1]) + (s1[2] + s1[3]));
        const float sc = 1.f / sqrtf(tot * (1.f / 512.f) + EPS);
        v4u* q = (v4u*)(p + F.lane * 16);
#pragma unroll
        for (int j = 0; j < 2; ++j) { v4u w = q[j]; v4u o;
            o.x = pk2(bflo(w.x) * sc, bfhi(w.x) * sc); o.y = pk2(bflo(w.y) * sc, bfhi(w.y) * sc); o.z = pk2(bflo(w.z) * sc, bfhi(w.z) * sc); o.w = pk2(bflo(w.w) * sc, bfhi(w.w) * sc); q[j] = o; }
    }
}
__device__ __forceinline__ float wave_dot_bf16(const bf16* x, const bf16* w, int n, int lane) {
    float s = 0.f;
    for (int i = lane * 8; i < n; i += 512) { const v4u a = *(const v4u*)(x + i), b = *(const v4u*)(w + i);
        s += bflo(a.x) * bflo(b.x) + bfhi(a.x) * bfhi(b.x) + bflo(a.y) * bflo(b.y) + bfhi(a.y) * bfhi(b.y) + bflo(a.z) * bflo(b.z) + bfhi(a.z) * bfhi(b.z) + bflo(a.w) * bflo(b.w) + bfhi(a.w) * bfhi(b.w); }
    return wave_sum(s);
}
__device__ __forceinline__ void p5_meta_tail(const Frame& F, const Args& a) {
    const int gw = F.vcu * NWAVES + F.wave, NGW = F.G * NWAVES;
    const bf16* mixmeta = (const bf16*)(a.ws + WS_MIXMETA); const bf16* WTout = (const bf16*)(a.ws + WS_WTOUT); float* h2m = (float*)(a.ws + WS_H2M);
    for (int o = gw; o < 2 * DM; o += NGW) { const int i = o / DM, n = o % DM;
        const float d = wave_dot_bf16(mixmeta + (size_t)(14 + i) * 2048, WTout + (size_t)n * 2048, 2048, F.lane);
        if (F.lane == 0) h2m[o] = a.in[IN_META][(size_t)(14 + i) * DM + n] + d; }
}
__device__ __forceinline__ void p6_meta_tail(const Frame& F, const Args& a) {
    const int gw = F.vcu * NWAVES + F.wave, NGW = F.G * NWAVES;
    const bf16* WTup = (const bf16*)(a.ws + WS_WTUP); const float* h2m = (const float*)(a.ws + WS_H2M); float* pmeta = (float*)(a.ws + WS_PMETA);
    for (int o = gw; o < 2 * NUP; o += NGW) { const int i = o / NUP, c = o % NUP; const int isv = c >= DFF, cc = isv ? c - DFF : c, n = (cc >> 7) * 256 + isv * 128 + (cc & 127);
        const float* h = h2m + (size_t)i * DM; const bf16* w = WTup + (size_t)n * DM; float s = 0.f, ss = 0.f;
        for (int k = F.lane * 8; k < DM; k += 512) { const f32x4 h0 = *(const f32x4*)(h + k), h1 = *(const f32x4*)(h + k + 4); const v4u b = *(const v4u*)(w + k);
            ss += (h0[0] * h0[0] + h0[1] * h0[1]) + (h0[2] * h0[2] + h0[3] * h0[3]) + (h1[0] * h1[0] + h1[1] * h1[1]) + (h1[2] * h1[2] + h1[3] * h1[3]);
            s += bf2f(f2bf(h0[0])) * bflo(b.x) + bf2f(f2bf(h0[1])) * bfhi(b.x) + bf2f(f2bf(h0[2])) * bflo(b.y) + bf2f(f2bf(h0[3])) * bfhi(b.y)
               + bf2f(f2bf(h1[0])) * bflo(b.z) + bf2f(f2bf(h1[1])) * bfhi(b.z) + bf2f(f2bf(h1[2])) * bflo(b.w) + bf2f(f2bf(h1[3])) * bfhi(b.w); }
        s = wave_sum(s); ss = wave_sum(ss);
        if (F.lane == 0) pmeta[o] = s / sqrtf(ss * (1.f / DM) + EPS); }
}
__device__ __forceinline__ void p7_conv_glu(const Frame& F, const Args& a) {
    bf16* proj = (bf16*)(a.ws + WS_PROJ); const bf16* halo = (const bf16*)(a.ws + WS_HALO); const float* pmeta = (const float*)(a.ws + WS_PMETA);
    const float* cw = a.in[IN_FCW]; const float* cb = a.in[IN_FCB];
    constexpr int CG = DFF / 8;
    const int NT = F.G * NWAVES * 64;
    for (int it = (F.vcu * NWAVES + F.wave) * 64 + F.lane; it < 256 * CG; it += NT) {
        const int rb = it / CG, c0 = (it % CG) * 8;
        const int vcol = (c0 < 1024) ? c0 : c0 + 3840;
        float wg[3][8], wv[3][8], bg[8], bv[8], g2[8], g1[8], v2[8], v1[8];
#pragma unroll
        for (int k = 0; k < 3; ++k)
#pragma unroll
            for (int j = 0; j < 8; ++j) { wg[k][j] = cw[k * NUP + c0 + j]; wv[k][j] = cw[k * NUP + DFF + c0 + j]; }
#pragma unroll
        for (int j = 0; j < 8; ++j) { bg[j] = cb[c0 + j]; bv[j] = cb[DFF + c0 + j]; }
        if ((rb & 63) == 0) {
#pragma unroll
            for (int j = 0; j < 8; ++j) { g2[j] = pmeta[c0 + j]; v2[j] = pmeta[DFF + c0 + j]; g1[j] = pmeta[NUP + c0 + j]; v1[j] = pmeta[NUP + DFF + c0 + j]; }
        } else {
            const bf16* h = halo + (size_t)((rb - 1) * 2) * NUP;
            const v4u a0 = *(const v4u*)(h + c0), a1 = *(const v4u*)(h + DFF + c0), b0 = *(const v4u*)(h + NUP + c0), b1 = *(const v4u*)(h + NUP + DFF + c0);
            g2[0] = bflo(a0.x); g2[1] = bfhi(a0.x); g2[2] = bflo(a0.y); g2[3] = bfhi(a0.y); g2[4] = bflo(a0.z); g2[5] = bfhi(a0.z); g2[6] = bflo(a0.w); g2[7] = bfhi(a0.w);
            v2[0] = bflo(a1.x); v2[1] = bfhi(a1.x); v2[2] = bflo(a1.y); v2[3] = bfhi(a1.y); v2[4] = bflo(a1.z); v2[5] = bfhi(a1.z); v2[6] = bflo(a1.w); v2[7] = bfhi(a1.w);
            g1[0] = bflo(b0.x); g1[1] = bfhi(b0.x); g1[2] = bflo(b0.y); g1[3] = bfhi(b0.y); g1[4] = bflo(b0.z); g1[5] = bfhi(b0.z); g1[6] = bflo(b0.w); g1[7] = bfhi(b0.w);
            v1[0] = bflo(b1.x); v1[1] = bfhi(b1.x); v1[2] = bflo(b1.y); v1[3] = bfhi(b1.y); v1[4] = bflo(b1.z); v1[5] = bfhi(b1.z); v1[6] = bflo(b1.w); v1[7] = bfhi(b1.w);
        }
        bf16* rowp = proj + (size_t)(rb * 64) * LDP;
#pragma unroll 2
        for (int r = 0; r < 64; ++r, rowp += LDP) {
            const v4u pg = *(const v4u*)(rowp + 2048 + c0), pv = *(const v4u*)(rowp + vcol);
            float g0[8], v0[8], o[8];
            g0[0] = bflo(pg.x); g0[1] = bfhi(pg.x); g0[2] = bflo(pg.y); g0[3] = bfhi(pg.y); g0[4] = bflo(pg.z); g0[5] = bfhi(pg.z); g0[6] = bflo(pg.w); g0[7] = bfhi(pg.w);
            v0[0] = bflo(pv.x); v0[1] = bfhi(pv.x); v0[2] = bflo(pv.y); v0[3] = bfhi(pv.y); v0[4] = bflo(pv.z); v0[5] = bfhi(pv.z); v0[6] = bflo(pv.w); v0[7] = bfhi(pv.w);
#pragma unroll
            for (int j = 0; j < 8; ++j) { const float ug = bg[j] + wg[0][j] * g2[j] + wg[1][j] * g1[j] + wg[2][j] * g0[j]; const float uv = bv[j] + wv[0][j] * v2[j] + wv[1][j] * v1[j] + wv[2][j] * v0[j];
                o[j] = siluf_(ug) * uv; g2[j] = g1[j]; g1[j] = g0[j]; v2[j] = v1[j]; v1[j] = v0[j]; }
            v4u w; w.x = pk2(o[0], o[1]); w.y = pk2(o[2], o[3]); w.z = pk2(o[4], o[5]); w.w = pk2(o[6], o[7]);
            *(v4u*)(rowp + 2048 + c0) = w;
        }
    }
}
__device__ __forceinline__ void p9_final_norm(const Frame& F, const Args& a) {
    const int gw = F.vcu * NWAVES + F.wave, NGW = F.G * NWAVES;
    const float* rss = (const float*)(a.ws + WS_SSQ); const f32x4* wv = (const f32x4*)a.in[IN_FNW] + F.lane;
    for (int m = gw; m < MREAL; m += NGW) {
        const f32x4* rp = (const f32x4*)(rss + (size_t)m * 16); const f32x4 sa = rp[0], sb = rp[1], sc_ = rp[2], sd = rp[3];
        const float tot = (((sa[0] + sa[1]) + (sa[2] + sa[3])) + ((sb[0] + sb[1]) + (sb[2] + sb[3]))) + (((sc_[0] + sc_[1]) + (sc_[2] + sc_[3])) + ((sd[0] + sd[1]) + (sd[2] + sd[3])));
        const float rs = 1.f / sqrtf(tot * (1.f / DM) + EPS);
        f32x4* o = (f32x4*)(a.out + (size_t)m * DM) + F.lane;
#pragma unroll
        for (int j = 0; j < 4; ++j) { const f32x4 v = o[64 * j], w = wv[64 * j]; o[64 * j] = v * rs * w; }
    }
}

namespace mix {
constexpr size_t DO_HGU = 0, DO_MBU = 16 * MiB, DO_HGD = 32 * MiB, DO_MBD = 33 * MiB, DO_SV = 40 * MiB, DO_XHALO = 48 * MiB;
typedef unsigned long long u64;
typedef short bf16x4 __attribute__((ext_vector_type(4)));
typedef short v4i16_t __attribute__((ext_vector_type(4)));
#define MFMA16(a, b, c) __builtin_amdgcn_mfma_f32_16x16x32_bf16((a), (b), (c), 0, 0, 0)

__device__ __forceinline__ unsigned row_off(int b, int p) { return (unsigned)(p < NMETA ? (MREAL + p) : b * SEQ + (p - NMETA)) * (unsigned)(LDP * 2); }
__device__ __forceinline__ float ldbf(const unsigned char* base, unsigned off) { return bf2f(*(const bf16*)(base + off)); }
__device__ __forceinline__ unsigned off256(unsigned row, unsigned ch) { return 272u * row + 16u * ch; }
__device__ __forceinline__ unsigned off128(unsigned row, unsigned ch) { return 144u * row + 16u * ch; }
__device__ __forceinline__ bf16x4 tr4(const LAS unsigned char* p) { return __builtin_bit_cast(bf16x4, __builtin_amdgcn_ds_read_tr16_b64_v4i16((LAS v4i16_t*)p)); }
__device__ __forceinline__ bf16x8 cat8(bf16x4 a, bf16x4 b) { return __builtin_shufflevector(a, b, 0, 1, 2, 3, 4, 5, 6, 7); }
__device__ __forceinline__ bf16x8 frag_nat(const LAS unsigned char* T, int rb, int s, int lane) { return *(const LAS bf16x8*)(T + off256((unsigned)((lane & 15) + 16 * rb), (unsigned)(4 * s + (lane >> 4)))); }
__device__ __forceinline__ bf16x8 frag_tr(const LAS unsigned char* T, int c, int ks, int lane) { const unsigned g = lane >> 4, q = (lane & 15) >> 2, p = lane & 3;
    return cat8(tr4(T + off256(32u * ks + 8u * g + q, 2u * c + (p >> 1)) + 8u * (p & 1)), tr4(T + off256(32u * ks + 8u * g + 4u + q, 2u * c + (p >> 1)) + 8u * (p & 1))); }
__device__ __forceinline__ bf16x8 frag_tr128(const LAS unsigned char* T, int c, int ks, int lane) { const unsigned g = lane >> 4, q = (lane & 15) >> 2, p = lane & 3;
    return cat8(tr4(T + off128(32u * ks + 8u * g + q, 2u * c + (p >> 1)) + 8u * (p & 1)), tr4(T + off128(32u * ks + 8u * g + 4u + q, 2u * c + (p >> 1)) + 8u * (p & 1))); }
__device__ __forceinline__ bf16x4 cl4(const LAS unsigned char* T, int R0, int c, int lane) { const unsigned g = lane >> 4, q = (lane & 15) >> 2, p = lane & 3; return tr4(T + off256((unsigned)R0 + 4u * g + q, 2u * c + (p >> 1)) + 8u * (p & 1)); }
__device__ __forceinline__ bf16x8 frag_perm(const LAS unsigned char* T, int rb, int ks, int lane) { const unsigned row = (lane & 15) + 16 * rb, g = lane >> 4;
    return cat8(*(const LAS bf16x4*)(T + off256(row, 4u * ks + (g >> 1)) + 8u * (g & 1)), *(const LAS bf16x4*)(T + off256(row, 4u * ks + 2u + (g >> 1)) + 8u * (g & 1))); }
__device__ __forceinline__ bf16x8 pack_state(const f32x4 a, const f32x4 b) { v4u w; w.x = pk2(a[0], a[1]); w.y = pk2(a[2], a[3]); w.z = pk2(b[0], b[1]); w.w = pk2(b[2], b[3]); return __builtin_bit_cast(bf16x8, w); }
__device__ __forceinline__ void unpack8(const v4u w, float* x) { x[0] = bflo(w.x); x[1] = bfhi(w.x); x[2] = bflo(w.y); x[3] = bfhi(w.y); x[4] = bflo(w.z); x[5] = bfhi(w.z); x[6] = bflo(w.w); x[7] = bfhi(w.w); }
__device__ __forceinline__ v4u pack8f(const float* x) { v4u w; w.x = pk2(x[0], x[1]); w.y = pk2(x[2], x[3]); w.z = pk2(x[4], x[5]); w.w = pk2(x[6], x[7]); return w; }
__device__ __forceinline__ float bf4(const bf16x4 v, int e) { return bf2f((unsigned short)v[e]); }

struct TileRegs { v4u r[2]; };
__device__ __forceinline__ void tile_issue(TileRegs& R, const unsigned char* pb, int b, int c, int colbytes, int tid) {
#pragma unroll
    for (int i = 0; i < 2; ++i) { const int q = tid + 512 * i, row = q >> 4, ch = q & 15, p = c * 64 + row - 48; R.r[i] = *(const v4u*)(pb + row_off(b, p >= 0 ? p : 0) + (unsigned)(colbytes + ch * 16)); }
}
__device__ __forceinline__ void tile_commit(const TileRegs& R, LAS unsigned char* T, int c, int tid) {
#pragma unroll
    for (int i = 0; i < 2; ++i) { const int q = tid + 512 * i, row = q >> 4, ch = q & 15, p = c * 64 + row - 48; *(LAS v4u*)(T + off256((unsigned)row, (unsigned)ch)) = p >= 0 ? R.r[i] : (v4u){0u, 0u, 0u, 0u}; }
}
__device__ __forceinline__ v4u ot_read(const LAS unsigned char* OT, int v0, int lane) { const unsigned g = lane >> 4, q = (lane & 15) >> 2, p = lane & 3;
    const bf16x4 lo = tr4(OT + off128((unsigned)v0 + q, 2u * g + (p >> 1)) + 8u * (p & 1)), hi = tr4(OT + off128((unsigned)v0 + 4u + q, 2u * g + (p >> 1)) + 8u * (p & 1)); return __builtin_bit_cast(v4u, cat8(lo, hi)); }

__device__ __forceinline__ int hg_sv_slot(int b, int h, int c) { return c == 0 ? 2048 + h : ((b * 8 + h) * 64 + c - 1); }
__device__ __forceinline__ void prep_hgrn2(LAS unsigned char* L, const Args& a, int item, int tid) {
    int b, h, c; if (item < 2048) { c = 1 + (item & 63); h = (item >> 6) & 7; b = item >> 9; } else { c = 0; b = 0; h = item - 2048; }
    unsigned char* pb = a.ws + WS_PROJ; float* SV = (float*)((unsigned char*)a.out + DO_SV) + (size_t)hg_sv_slot(b, h, c) * 384;
    LAS float* segtot = (LAS float*)L; LAS float* bmv = (LAS float*)(L + 16384);
    const int cg = tid & 15, rs = tid >> 4;
    const int p0 = c * 64 + 2 * rs - 48, p1 = p0 + 1; const bool ok0 = p0 >= 0, ok1 = p1 >= 0;
    const unsigned ro0 = row_off(b, ok0 ? p0 : 0) + (unsigned)(h * 128 + cg * 8) * 2u, ro1 = row_off(b, ok1 ? p1 : 0) + (unsigned)(h * 128 + cg * 8) * 2u;
    float lf0[8], lf1[8], q0[8], q1[8];
    { const v4u a0 = *(const v4u*)(pb + ro0 + F0 * 2), a1 = *(const v4u*)(pb + ro1 + F0 * 2), b0 = *(const v4u*)(pb + ro0 + Q0 * 2), b1 = *(const v4u*)(pb + ro1 + Q0 * 2);
      unpack8(a0, lf0); unpack8(a1, lf1); unpack8(b0, q0); unpack8(b1, q1); }
#pragma unroll
    for (int j = 0; j < 8; ++j) { if (!ok0) { lf0[j] = 0.f; q0[j] = 0.f; } if (!ok1) { lf1[j] = 0.f; q1[j] = 0.f; } }
    { f32x4 s0, s1;
#pragma unroll
      for (int j = 0; j < 4; ++j) { s0[j] = lf0[j] + lf1[j]; s1[j] = lf0[4 + j] + lf1[4 + j]; }
      *(LAS f32x4*)(segtot + rs * 128 + cg * 8) = s0; *(LAS f32x4*)(segtot + rs * 128 + cg * 8 + 4) = s1; }
    __syncthreads();
    if (tid < 128) { float run = 0.f, bmid = 0.f;
#pragma unroll 8
        for (int s_ = 0; s_ < 32; ++s_) { const float v = segtot[s_ * 128 + tid]; segtot[s_ * 128 + tid] = run; if (s_ == 16) bmid = run; run += v; }
        bmv[tid] = bmid; SV[tid] = __expf(run); SV[128 + tid] = __expf(run - bmid); SV[256 + tid] = __expf(bmid); }
    __syncthreads();
    { const f32x4 o0 = *(const LAS f32x4*)(segtot + rs * 128 + cg * 8), o1 = *(const LAS f32x4*)(segtot + rs * 128 + cg * 8 + 4), m0 = *(const LAS f32x4*)(bmv + cg * 8), m1 = *(const LAS f32x4*)(bmv + cg * 8 + 4);
      float qd0[8], qd1[8], ki0[8], ki1[8];
#pragma unroll
      for (int j = 0; j < 8; ++j) { const float off = j < 4 ? o0[j] : o1[j - 4], bm = j < 4 ? m0[j] : m1[j - 4]; const float bc0 = off + lf0[j], bc1 = bc0 + lf1[j];
          qd0[j] = q0[j] * __expf(bc0 - bm); qd1[j] = q1[j] * __expf(bc1 - bm); ki0[j] = (1.f - __expf(lf0[j])) * __expf(bm - bc0); ki1[j] = (1.f - __expf(lf1[j])) * __expf(bm - bc1); }
      if (ok0) { *(v4u*)(pb + ro0 + Q0 * 2) = pack8f(qd0); *(v4u*)(pb + ro0 + F0 * 2) = pack8f(ki0); }
      if (ok1) { *(v4u*)(pb + ro1 + Q0 * 2) = pack8f(qd1); *(v4u*)(pb + ro1 + F0 * 2) = pack8f(ki1); } }
    __syncthreads();
}
__device__ __forceinline__ void prep_mamba(const Args& a, int item, int tid) {
    int b, grp, c; if (item < 512) { c = 1 + (item & 63); grp = (item >> 6) & 1; b = item >> 7; } else { c = 0; b = 0; grp = item - 512; }
    unsigned char* pb = a.ws + WS_PROJ; const unsigned char* xh = (const unsigned char*)a.out + DO_XHALO;
    const int cc = tid % 96, rsg = tid / 96; const bool act = tid < 480;
    const int col = cc < 64 ? grp * 512 + cc * 8 : (cc < 80 ? 1024 + grp * 128 + (cc - 64) * 8 : 1280 + grp * 128 + (cc - 80) * 8);
    const int rlo = rsg * 13;
    v4u raw[16];
#pragma unroll
    for (int i = 0; i < 16; ++i) { const int r = rlo - 3 + i, p = c * 64 + r - 48; v4u v = (v4u){0u, 0u, 0u, 0u};
        if (act && p >= 0 && r < 64) { if (r >= 0) v = *(const v4u*)(pb + row_off(b, p) + (unsigned)(XBC0 + col) * 2u);
            else { const int slot = (c == 1) ? 256 : b * 64 + (c - 2); v = *(const v4u*)(xh + ((size_t)(slot * 3 + r + 3) * 1536 + col) * 2); } }
        raw[i] = v; }
    float w[4][8], bia[8];
    { const float* cw = a.in[IN_CW]; const float* cb = a.in[IN_CB];
#pragma unroll
      for (int k = 0; k < 4; ++k) { const f32x4 w0 = *(const f32x4*)(cw + k * 1536 + col), w1 = *(const f32x4*)(cw + k * 1536 + col + 4);
#pragma unroll
          for (int j = 0; j < 4; ++j) { w[k][j] = w0[j]; w[k][4 + j] = w1[j]; } }
      const f32x4 b0 = *(const f32x4*)(cb + col), b1 = *(const f32x4*)(cb + col + 4);
#pragma unroll
      for (int j = 0; j < 4; ++j) { bia[j] = b0[j]; bia[4 + j] = b1[j]; } }
    __syncthreads();
    float x0[8], x1[8], x2[8], x3[8];
    unpack8(raw[0], x0); unpack8(raw[1], x1); unpack8(raw[2], x2);
#pragma unroll
    for (int i = 0; i < 13; ++i) { unpack8(raw[i + 3], x3); const int r = rlo + i, p = c * 64 + r - 48; float o[8];
#pragma unroll
        for (int j = 0; j < 8; ++j) { o[j] = siluf_(bia[j] + w[0][j] * x0[j] + w[1][j] * x1[j] + w[2][j] * x2[j] + w[3][j] * x3[j]); x0[j] = x1[j]; x1[j] = x2[j]; x2[j] = x3[j]; }
        if (act && p >= 0 && r < 64) *(v4u*)(pb + row_off(b, p) + (unsigned)(XBC0 + col) * 2u) = pack8f(o); }
}

template <bool OUT>
__device__ __forceinline__ void hgrn2_item(LAS unsigned char* L, const Args& a, int bh, int j, int tid, int wave, int lane) {
    const int b = bh >> 3, h = bh & 7, n = lane & 15, g = lane >> 4;
    unsigned char* pb = a.ws + WS_PROJ; bf16* mixmeta = (bf16*)(a.ws + WS_MIXMETA);
    float* HGU = (float*)((unsigned char*)a.out + DO_HGU); float* HGD = (float*)((unsigned char*)a.out + DO_HGD); const float* SVg = (const float*)((const unsigned char*)a.out + DO_SV);
    LAS unsigned char* T_QD = L; LAS unsigned char* T_KI = L + 17408; LAS unsigned char* T_V = L + 34816; LAS unsigned char* T_G = L + 52224; LAS unsigned char* T_SC = L + 69632; LAS unsigned char* T_OT = L + 78848;
    LAS float* sv = (LAS float*)(L + 97280); LAS float* red = (LAS float*)(L + 97280 + 2048); LAS float* rinv = (LAS float*)(L + 97280 + 4096);
    f32x4 S[8];
#pragma unroll
    for (int kt = 0; kt < 8; ++kt) S[kt] = (f32x4){0.f, 0.f, 0.f, 0.f};
    f32x4 Dp[8];
    if (OUT) {
        for (int i = 0; i < j; ++i) { const float* U = HGU + ((size_t)(bh * 7 + i)) * 16384 + (size_t)(wave * 8 * 64 + lane) * 4; const float* D = HGD + (size_t)(bh * 7 + i) * 128 + 4 * g;
#pragma unroll
            for (int kt = 0; kt < 8; ++kt) { const f32x4 d4 = *(const f32x4*)(D + kt * 16), u4 = *(const f32x4*)(U + kt * 256); S[kt] = S[kt] * d4 + u4; } }
    } else {
#pragma unroll
        for (int kt = 0; kt < 8; ++kt) Dp[kt] = (f32x4){1.f, 1.f, 1.f, 1.f};
    }
    const int c0 = j == 0 ? 0 : 8 * j + 1, c1 = 8 * j + 8;
    TileRegs RQ, RK, RV, RG; f32x4 Rsv = (f32x4){0.f, 0.f, 0.f, 0.f};
#define HG_ISSUE(cn) do { const int cb_ = (h * 128) * 2; if (OUT) { tile_issue(RQ, pb, b, (cn), Q0 * 2 + cb_, tid); tile_issue(RG, pb, b, (cn), G0 * 2 + cb_, tid); } \
        tile_issue(RK, pb, b, (cn), F0 * 2 + cb_, tid); tile_issue(RV, pb, b, (cn), I0 * 2 + cb_, tid); \
        if (tid < 96) Rsv = *(const f32x4*)(SVg + (size_t)hg_sv_slot(b, h, (cn)) * 384 + tid * 4); } while (0)
    HG_ISSUE(c0);
    const int tid_in = tid, lane_in = lane;
    for (int c = c0; c <= c1; ++c) {
        int tid = tid_in, lane = lane_in; asm volatile("" : "+v"(tid), "+v"(lane));
        const int n = lane & 15, g = lane >> 4;
        if (OUT) { tile_commit(RQ, T_QD, c, tid); tile_commit(RG, T_G, c, tid); }
        tile_commit(RK, T_KI, c, tid); tile_commit(RV, T_V, c, tid);
        if (tid < 96) *(LAS f32x4*)(sv + tid * 4) = Rsv;
        if (c < c1) HG_ISSUE(c + 1);
        __syncthreads();
        bf16x8 vf[2];
#pragma unroll
        for (int ts = 0; ts < 2; ++ts) vf[ts] = frag_tr(T_V, wave, ts, lane);
        f32x4 O[4]; bf16x4 gq[4];
        if (OUT) {
            const int ti = wave >> 1;
#pragma unroll
            for (int q = 0; q < 2; ++q) { const int si = 2 * (wave & 1) + q; f32x4 acc = (f32x4){0.f, 0.f, 0.f, 0.f};
                if (si <= ti) {
#pragma unroll
                    for (int ks = 0; ks < 4; ++ks) acc = MFMA16(frag_nat(T_QD, ti, ks, lane), frag_nat(T_KI, si, ks, lane), acc); }
                float m[4];
#pragma unroll
                for (int r = 0; r < 4; ++r) m[r] = (ti * 16 + 4 * g + r >= si * 16 + n) ? acc[r] : 0.f;
                u64 w = (u64)pk2(m[0], m[1]) | ((u64)pk2(m[2], m[3]) << 32);
                *(LAS u64*)(T_SC + off128((unsigned)(si * 16 + n), (unsigned)(2 * ti + (g >> 1))) + 8u * (g & 1)) = w; }
#pragma unroll
            for (int tt = 0; tt < 4; ++tt) gq[tt] = cl4(T_G, tt * 16, wave, lane);
            __syncthreads();
#pragma unroll
            for (int tt = 0; tt < 4; ++tt) { O[tt] = (f32x4){0.f, 0.f, 0.f, 0.f};
#pragma unroll
                for (int ss = 0; ss < 2; ++ss) if (ss * 32 <= tt * 16 + 15) O[tt] = MFMA16(frag_tr128(T_SC, tt, ss, lane), vf[ss], O[tt]); }
            bf16x8 sb[4];
#pragma unroll
            for (int ks = 0; ks < 4; ++ks) { const f32x4 e0 = *(const LAS f32x4*)(sv + 256 + (2 * ks) * 16 + 4 * g), e1 = *(const LAS f32x4*)(sv + 256 + (2 * ks + 1) * 16 + 4 * g); sb[ks] = pack_state(S[2 * ks] * e0, S[2 * ks + 1] * e1); }
#pragma unroll
            for (int tt = 0; tt < 4; ++tt)
#pragma unroll
                for (int ks = 0; ks < 4; ++ks) O[tt] = MFMA16(frag_perm(T_QD, tt, ks, lane), sb[ks], O[tt]);
        }
#pragma unroll
        for (int kt = 0; kt < 8; ++kt) { f32x4 T = (f32x4){0.f, 0.f, 0.f, 0.f};
#pragma unroll
            for (int ts = 0; ts < 2; ++ts) T = MFMA16(frag_tr(T_KI, kt, ts, lane), vf[ts], T);
            const f32x4 d4 = *(const LAS f32x4*)(sv + kt * 16 + 4 * g), e4 = *(const LAS f32x4*)(sv + 128 + kt * 16 + 4 * g); S[kt] = S[kt] * d4 + e4 * T;
            if (!OUT) Dp[kt] = Dp[kt] * d4; }
        if (OUT) {
#pragma unroll
            for (int tt = 0; tt < 4; ++tt)
#pragma unroll
                for (int r = 0; r < 4; ++r) { float ss = O[tt][r] * O[tt][r]; ss += __shfl_xor(ss, 1); ss += __shfl_xor(ss, 2); ss += __shfl_xor(ss, 4); ss += __shfl_xor(ss, 8); if (n == 0) red[wave * 64 + tt * 16 + 4 * g + r] = ss; }
            __syncthreads();
            if (tid < 64) { float tot = 0.f;
#pragma unroll
                for (int w = 0; w < 8; ++w) tot += red[w * 64 + tid];
                rinv[tid] = 1.f / sqrtf(tot * (1.f / 128.f) + EPS); }
            __syncthreads();
            const float nw = a.in[IN_HGNW][h * 128 + wave * 16 + n];
#pragma unroll
            for (int tt = 0; tt < 4; ++tt) { const f32x4 ri = *(const LAS f32x4*)(rinv + tt * 16 + 4 * g); float o[4];
#pragma unroll
                for (int r = 0; r < 4; ++r) o[r] = O[tt][r] * ri[r] * nw * bf4(gq[tt], r);
                *(LAS u64*)(T_OT + off128((unsigned)(wave * 16 + n), (unsigned)(2 * tt + (g >> 1))) + 8u * (g & 1)) = (u64)pk2(o[0], o[1]) | ((u64)pk2(o[2], o[3]) << 32); }
            LDS_WAIT();
#pragma unroll
            for (int hf = 0; hf < 2; ++hf) { const v4u w = ot_read(T_OT, wave * 16 + 8 * hf, lane); const int p = c * 64 + 16 * g + n - 48, vc = h * 128 + wave * 16 + 8 * hf;
                if (p >= NMETA) *(v4u*)(pb + row_off(b, p) + (unsigned)(Q0 + vc) * 2u) = w;
                else if (p >= 0 && b == 0) *(v4u*)(mixmeta + (size_t)p * 2048 + vc) = w; }
        } else {
            __syncthreads();
        }
    }
#undef HG_ISSUE
    if (!OUT) {
        float* U = HGU + ((size_t)(bh * 7 + j)) * 16384 + (size_t)(wave * 8 * 64 + lane) * 4;
#pragma unroll
        for (int kt = 0; kt < 8; ++kt) *(f32x4*)(U + kt * 256) = S[kt];
        if (wave == 0 && n == 0) {
#pragma unroll
            for (int kt = 0; kt < 8; ++kt) *(f32x4*)(HGD + (size_t)(bh * 7 + j) * 128 + kt * 16 + 4 * g) = Dp[kt]; }
    }
}

template <bool OUT>
__device__ __forceinline__ void mamba_item(LAS unsigned char* L, const Args& a, int bp, int j, int tid, int wave, int lane) {
    const int b = bp >> 3, pair = bp & 7, grp = pair >> 2, hm0 = 2 * pair, n = lane & 15, g = lane >> 4, whd = wave >> 2;
    unsigned char* pb = a.ws + WS_PROJ; bf16* mixmeta = (bf16*)(a.ws + WS_MIXMETA); float* ssq = (float*)(a.ws + WS_SSQ);
    float* MBU = (float*)((unsigned char*)a.out + DO_MBU); float* MBD = (float*)((unsigned char*)a.out + DO_MBD);
    LAS unsigned char* T_X = L; LAS unsigned char* T_B = L + 17408; LAS unsigned char* T_C = L + 34816; LAS unsigned char* T_Z = L + 52224; LAS unsigned char* T_VE = L + 69632; LAS unsigned char* T_SC = L + 87040; LAS unsigned char* T_OT = L + 105472;
    LAS float* acum = (LAS float*)(L + 123904); LAS float* eac = acum + 128; LAS float* wv = acum + 256; LAS float* dtv = acum + 384; LAS float* eal = acum + 512; LAS float* red = acum + 576;
    f32x4 S[8];
#pragma unroll
    for (int kt = 0; kt < 8; ++kt) S[kt] = (f32x4){0.f, 0.f, 0.f, 0.f};
    if (OUT) {
        for (int i = 0; i < j; ++i) { const float* U = MBU + ((size_t)(bp * 7 + i)) * 16384 + (size_t)(wave * 8 * 64 + lane) * 4; const float d = MBD[(size_t)(bp * 7 + i) * 2 + whd];
#pragma unroll
            for (int kt = 0; kt < 8; ++kt) { const f32x4 u4 = *(const f32x4*)(U + kt * 256); S[kt] = S[kt] * d + u4; } }
    }
    float dprod = 1.f;
    const float Ah = -__expf(a.in[IN_ALOG][hm0 + (wave & 1)]);
    const int c0 = j == 0 ? 0 : 8 * j + 1, c1 = 8 * j + 8;
    TileRegs RX, RB, RC, RZ; float Rdt = 0.f;
#define MB_ISSUE(cn) do { tile_issue(RX, pb, b, (cn), (XBC0 + hm0 * 64) * 2, tid); tile_issue(RB, pb, b, (cn), (XBC0 + 1024 + grp * 128) * 2, tid); \
        if (OUT) { tile_issue(RC, pb, b, (cn), (XBC0 + 1280 + grp * 128) * 2, tid); tile_issue(RZ, pb, b, (cn), (Z0 + hm0 * 64) * 2, tid); } \
        if (wave < 2) { const int p_ = (cn) * 64 + lane - 48; const float d_ = ldbf(pb, row_off(b, p_ >= 0 ? p_ : 0) + (unsigned)(DT0 + hm0 + wave) * 2u); Rdt = p_ >= 0 ? d_ : 0.f; } } while (0)
    MB_ISSUE(c0);
    const int tid_in = tid, lane_in = lane;
    for (int c = c0; c <= c1; ++c) {
        int tid = tid_in, lane = lane_in; asm volatile("" : "+v"(tid), "+v"(lane));
        const int n = lane & 15, g = lane >> 4;
        tile_commit(RX, T_X, c, tid); tile_commit(RB, T_B, c, tid);
        if (OUT) { tile_commit(RC, T_C, c, tid); tile_commit(RZ, T_Z, c, tid); }
        if (wave < 2) {
            float ac = Rdt * Ah;
#pragma unroll
            for (int o = 1; o < 64; o <<= 1) { const float t_ = __shfl_up(ac, o); if (lane >= o) ac += t_; }
            const float alast = __shfl(ac, 63);
            acum[wave * 64 + lane] = ac; eac[wave * 64 + lane] = __expf(ac); wv[wave * 64 + lane] = Rdt * __expf(alast - ac); dtv[wave * 64 + lane] = Rdt;
            if (lane == 0) eal[wave] = __expf(alast);
        }
        __syncthreads();
#pragma unroll
        for (int i = 0; i < 2; ++i) { const int q = tid + 512 * i, row = q >> 4, ch = q & 15, p = c * 64 + row - 48; float x[8]; unpack8(RX.r[i], x); const float w_ = p >= 0 ? wv[(ch >> 3) * 64 + row] : 0.f;
#pragma unroll
            for (int e = 0; e < 8; ++e) x[e] *= w_;
            *(LAS v4u*)(T_VE + off256((unsigned)row, (unsigned)ch)) = pack8f(x); }
        if (c < c1) MB_ISSUE(c + 1);
        f32x4 O[4]; bf16x4 xq[4], zq[4];
        if (OUT) {
            const int ti = wave >> 1;
#pragma unroll
            for (int q = 0; q < 2; ++q) { const int si = 2 * (wave & 1) + q; f32x4 acc = (f32x4){0.f, 0.f, 0.f, 0.f};
                if (si <= ti) {
#pragma unroll
                    for (int ks = 0; ks < 4; ++ks) acc = MFMA16(frag_nat(T_C, ti, ks, lane), frag_nat(T_B, si, ks, lane), acc); }
#pragma unroll
                for (int h2 = 0; h2 < 2; ++h2) { const f32x4 at = *(const LAS f32x4*)(acum + h2 * 64 + ti * 16 + 4 * g); const float as = acum[h2 * 64 + si * 16 + n], ds = dtv[h2 * 64 + si * 16 + n]; float m[4];
#pragma unroll
                    for (int r = 0; r < 4; ++r) m[r] = (ti * 16 + 4 * g + r >= si * 16 + n) ? acc[r] * __expf(at[r] - as) * ds : 0.f;
                    *(LAS u64*)(T_SC + h2 * 9216 + off128((unsigned)(si * 16 + n), (unsigned)(2 * ti + (g >> 1))) + 8u * (g & 1)) = (u64)pk2(m[0], m[1]) | ((u64)pk2(m[2], m[3]) << 32); } }
#pragma unroll
            for (int tt = 0; tt < 4; ++tt) { xq[tt] = cl4(T_X, tt * 16, wave, lane); zq[tt] = cl4(T_Z, tt * 16, wave, lane); }
        }
        __syncthreads();
        if (OUT) {
            bf16x8 xf[2];
#pragma unroll
            for (int ss = 0; ss < 2; ++ss) xf[ss] = frag_tr(T_X, wave, ss, lane);
            f32x4 O2[4];
#pragma unroll
            for (int tt = 0; tt < 4; ++tt) { O[tt] = (f32x4){0.f, 0.f, 0.f, 0.f}; O2[tt] = (f32x4){0.f, 0.f, 0.f, 0.f};
#pragma unroll
                for (int ss = 0; ss < 2; ++ss) if (ss * 32 <= tt * 16 + 15) O[tt] = MFMA16(frag_tr128(T_SC + whd * 9216, tt, ss, lane), xf[ss], O[tt]); }
            bf16x8 sb[4];
#pragma unroll
            for (int ks = 0; ks < 4; ++ks) sb[ks] = pack_state(S[2 * ks], S[2 * ks + 1]);
#pragma unroll
            for (int tt = 0; tt < 4; ++tt)
#pragma unroll
                for (int ks = 0; ks < 4; ++ks) O2[tt] = MFMA16(frag_perm(T_C, tt, ks, lane), sb[ks], O2[tt]);
#pragma unroll
            for (int tt = 0; tt < 4; ++tt) { const f32x4 ea = *(const LAS f32x4*)(eac + whd * 64 + tt * 16 + 4 * g); O[tt] = O[tt] + ea * O2[tt]; }
        }
        { const float el = eal[whd]; bf16x8 vef[2];
#pragma unroll
          for (int ts = 0; ts < 2; ++ts) vef[ts] = frag_tr(T_VE, wave, ts, lane);
#pragma unroll
          for (int kt = 0; kt < 8; ++kt) { f32x4 T = S[kt] * el;
#pragma unroll
            for (int ts = 0; ts < 2; ++ts) T = MFMA16(frag_tr(T_B, kt, ts, lane), vef[ts], T);
            S[kt] = T; }
          if (!OUT) dprod *= el; }
        if (OUT) {
            float y[4][4];
            const float Dw = a.in[IN_D][hm0 + whd], nw = a.in[IN_M2NW][hm0 * 64 + wave * 16 + n];
#pragma unroll
            for (int tt = 0; tt < 4; ++tt)
#pragma unroll
                for (int r = 0; r < 4; ++r) { y[tt][r] = (O[tt][r] + Dw * bf4(xq[tt], r)) * bf4(zq[tt], r);
                    float ss = y[tt][r] * y[tt][r]; ss += __shfl_xor(ss, 1); ss += __shfl_xor(ss, 2); ss += __shfl_xor(ss, 4); ss += __shfl_xor(ss, 8); if (n == 0) red[wave * 64 + tt * 16 + 4 * g + r] = ss; }
#pragma unroll
            for (int tt = 0; tt < 4; ++tt)
                *(LAS u64*)(T_OT + off128((unsigned)(wave * 16 + n), (unsigned)(2 * tt + (g >> 1))) + 8u * (g & 1)) = (u64)pk2(y[tt][0] * nw, y[tt][1] * nw) | ((u64)pk2(y[tt][2] * nw, y[tt][3] * nw) << 32);
            __syncthreads();
            if (tid < 128) { const int h2 = tid >> 6, t = tid & 63; const float tot = (red[(4 * h2) * 64 + t] + red[(4 * h2 + 1) * 64 + t]) + (red[(4 * h2 + 2) * 64 + t] + red[(4 * h2 + 3) * 64 + t]);
                const int p = c * 64 + t - 48; if (p >= NMETA || (p >= 0 && b == 0)) ssq[(size_t)(p < NMETA ? MREAL + p : b * SEQ + p - NMETA) * 16 + hm0 + h2] = tot; }
#pragma unroll
            for (int hf = 0; hf < 2; ++hf) { const v4u w = ot_read(T_OT, wave * 16 + 8 * hf, lane); const int p = c * 64 + 16 * g + n - 48, vc = hm0 * 64 + wave * 16 + 8 * hf;
                if (p >= NMETA) *(v4u*)(pb + row_off(b, p) + (unsigned)(Z0 + vc) * 2u) = w;
                else if (p >= 0 && b == 0) *(v4u*)(mixmeta + (size_t)p * 2048 + 1024 + vc) = w; }
        } else {
            __syncthreads();
        }
    }
#undef MB_ISSUE
    if (!OUT) {
        float* U = MBU + ((size_t)(bp * 7 + j)) * 16384 + (size_t)(wave * 8 * 64 + lane) * 4;
#pragma unroll
        for (int kt = 0; kt < 8; ++kt) *(f32x4*)(U + kt * 256) = S[kt];
        if ((wave & 3) == 0 && lane == 0) MBD[(size_t)(bp * 7 + j) * 2 + whd] = dprod;
    }
}
#undef MFMA16
}

__global__ void __launch_bounds__(NWAVES * 64, 2) mk_fwd(Args args) {
    extern __shared__ __attribute__((aligned(16))) unsigned char lds[];
    Frame F;
    F.lds = (LAS unsigned char*)lds;
    F.tid = threadIdx.x; F.lane = F.tid & 63; F.wave = __builtin_amdgcn_readfirstlane(F.tid >> 6);
    F.G = gridDim.x; { const int bx = blockIdx.x; F.vcu = (F.G % 8 == 0) ? (bx % 8) * (F.G / 8) + bx / 8 : bx; }
    volatile LAS unsigned* MISC = (volatile LAS unsigned*)(F.lds + MISC_OFF);
    unsigned char* ws = args.ws;
    for (int u = F.tid; u < (LDS_BYTES - LDSCTL_OFF) / 4; u += NWAVES * 64) ((LAS unsigned*)(F.lds + LDSCTL_OFF))[u] = 0u;
    __syncthreads();
    const int lo = args.ph_lo, hi = args.ph_hi;
    const bool use_bar = (hi - lo) > 1;
    XcdBarrier bar; bar.bar = (unsigned*)(ws + WS_CTL) + CW_BAR; bar.x = 0; bar.st = nullptr;
    if (use_bar) bar = xcd_barrier_post((unsigned*)(ws + WS_CTL) + CW_BAR, MISC + 8);
#define IN(k) (lo <= (k) && (k) < hi)
#define SEAM(k) do { if (IN(k) && IN((k) + 1)) xcd_barrier(bar); } while (0)
    bf16* proj = (bf16*)(ws + WS_PROJ);

#define PRB_BEGIN(k) do { if (MK_PROBE_LO == (k) && blockIdx.x == 0 && F.tid == 0) *(volatile LAS unsigned long long*)(MISC + 16) = __builtin_amdgcn_s_memrealtime(); } while (0)
#define PRB_END(k) do { if (MK_PROBE_HI == (k) && blockIdx.x == 0 && F.tid == 0) *(volatile LAS unsigned long long*)(MISC + 18) = __builtin_amdgcn_s_memrealtime(); } while (0)
    PRB_BEGIN(0);
    if (IN(0)) { p0_prologue(F, args); SEAM(0); }
    PRB_END(0); PRB_BEGIN(1);
    if (IN(1)) {
        pg8::Gemm g{(const bf16*)((unsigned char*)args.out + DO_U), (const bf16*)((unsigned char*)args.out + DO_WTIN), M1, LDP, DM, DM, 1 << 30, 0};
        pg8::StaticOrder S; S.init(M1, LDP, F.G, (int)blockIdx.x);
        pg8::EpiProj E{proj, LDP, args.in[IN_LBL], args.in[IN_DTB], (bf16*)((unsigned char*)args.out + mix::DO_XHALO)};
        pg8::gemm_phase<pg8::EpiProj, pg8::StaticOrder, true, true>(F.lds + RING_OFF, g, S, E);
        SEAM(1);
    }
    PRB_END(1); PRB_BEGIN(2);
    if (IN(2)) {
        for (int it = F.vcu; it < 514 + 2056; it += F.G) {
            if (it < 514) mix::prep_mamba(args, it, F.tid); else mix::prep_hgrn2(F.lds + RING_OFF, args, it - 514, F.tid);
        }
        SEAM(2);
    }
    PRB_END(2); PRB_BEGIN(3);
    if (IN(3)) {
        for (int it = F.vcu; it < 448; it += F.G) {
            if (it < 224) mix::hgrn2_item<false>(F.lds + RING_OFF, args, it / 7, it % 7, F.tid, F.wave, F.lane);
            else mix::mamba_item<false>(F.lds + RING_OFF, args, (it - 224) / 7, (it - 224) % 7, F.tid, F.wave, F.lane);
        }
        SEAM(3);
    }
    PRB_END(3); PRB_BEGIN(4);
    if (IN(4)) {
        for (int it = F.vcu; it < 256; it += F.G) { mix::hgrn2_item<true>(F.lds + RING_OFF, args, it >> 3, it & 7, F.tid, F.wave, F.lane); __syncthreads(); }
        { int tid2 = F.tid; asm volatile("" : "+v"(tid2));
          const int lane2 = tid2 & 63, wave2 = __builtin_amdgcn_readfirstlane(tid2 >> 6);
          for (int it = F.vcu; it < 256; it += F.G) { mix::mamba_item<true>(F.lds + RING_OFF, args, it >> 3, 7 - (it & 7), tid2, wave2, lane2); __syncthreads(); } }
        SEAM(4);
    }
    PRB_END(4); PRB_BEGIN(5);
    if (IN(5)) { p4_groupnorm(F, args); SEAM(5); }
    PRB_END(5); PRB_BEGIN(6);
    if (IN(6)) {
        p5_meta_tail(F, args); VM_WAIT(); __syncthreads();
        pg8::Gemm g{proj, (const bf16*)(ws + WS_WTOUT), MREAL, DM, 2048, LDP, 16, (Z0 - 1024) * 2};
        pg8::StaticOrder S; S.init(MREAL, DM, F.G, (int)blockIdx.x);
        pg8::EpiResid<true> E{args.in[IN_X], args.out, proj + F0, LDP, (float*)(ws + WS_RSS)};
        pg8::gemm_phase<pg8::EpiResid<true>, pg8::StaticOrder, false, true>(F.lds + RING_OFF, g, S, E);
        SEAM(6);
    }
    PRB_END(6); PRB_BEGIN(7);
    if (IN(7)) {
        p6_meta_tail(F, args); VM_WAIT(); __syncthreads();
        pg8::Gemm g{proj + F0, (const bf16*)(ws + WS_WTUP), MREAL, NUP, DM, LDP, 1 << 30, 0};
        pg8::StaticOrder S; S.init(MREAL, NUP, F.G, (int)blockIdx.x);
        pg8::EpiUp E{proj, (const float*)(ws + WS_RSS), (bf16*)(ws + WS_HALO)};
        pg8::gemm_phase<pg8::EpiUp, pg8::StaticOrder, true, true>(F.lds + RING_OFF, g, S, E);
        SEAM(7);
    }
    PRB_END(7); PRB_BEGIN(8);
    if (IN(8)) { p7_conv_glu(F, args); SEAM(8); }
    PRB_END(8); PRB_BEGIN(9);
    if (IN(9)) {
        pg8::Gemm g{proj + 2048, (const bf16*)(ws + WS_WTDN), MREAL, DM, DFF, LDP, 1 << 30, 0};
        pg8::StaticOrder S; S.init(MREAL, DM, F.G, (int)blockIdx.x);
        pg8::EpiResid<false> E{args.out, args.out, nullptr, 0, (float*)(ws + WS_SSQ)};
        pg8::gemm_phase<pg8::EpiResid<false>, pg8::StaticOrder, false, true>(F.lds + RING_OFF, g, S, E);
        SEAM(9);
    }
    PRB_END(9); PRB_BEGIN(10);
    if (IN(10)) { p9_final_norm(F, args); }
    PRB_END(10);
    if (MK_PROBE_LO >= 0 && blockIdx.x == 0 && F.tid == 0) { const unsigned long long want = (unsigned long long)MK_PROBE_MULT * (*(volatile LAS unsigned long long*)(MISC + 18) - *(volatile LAS unsigned long long*)(MISC + 16)), t0 = __builtin_amdgcn_s_memrealtime();
        while (__builtin_amdgcn_s_memrealtime() - t0 < want) __builtin_amdgcn_s_sleep(8); }
#undef PRB_BEGIN
#undef PRB_END
#undef IN
#undef SEAM
}

extern "C" void kernel_launch(void* const* d_in, const int* in_sizes, int n_in, void* d_out, int out_size, void* d_ws, size_t ws_size, hipStream_t stream) {
    static int grid = 0;
    if (grid == 0) {
        if (n_in != 19 || in_sizes[0] != MREAL * DM || out_size != MREAL * DM || ws_size < WS_END) { fprintf(stderr, "kernel_launch: unexpected shapes (n_in %d, in0 %d, out %d, ws %zu); nothing launched\n", n_in, n_in > 0 ? in_sizes[0] : -1, out_size, ws_size); grid = -1; return; }
        int dev = 0, cus = 0;
        if (hipGetDevice(&dev) != hipSuccess || hipDeviceGetAttribute(&cus, hipDeviceAttributeMultiprocessorCount, dev) != hipSuccess) { grid = -1; return; }
        if (hipFuncSetAttribute((const void*)mk_fwd, hipFuncAttributeMaxDynamicSharedMemorySize, LDS_BYTES) != hipSuccess) { fprintf(stderr, "kernel_launch: hipFuncSetAttribute failed\n"); grid = -1; return; }
        (void)hipGetLastError();
        grid = cus;
    }
    if (grid < 0) return;
    if (hipMemsetAsync((char*)d_ws + WS_CTL, 0, CTL_ZERO_BYTES, stream) != hipSuccess) { fprintf(stderr, "kernel_launch: memset failed\n"); return; }
    Args a{};
    for (int i = 0; i < 19; ++i) a.in[i] = (const float*)d_in[i];
    a.out = (float*)d_out; a.ws = (unsigned char*)d_ws;
#if MK_PER_PHASE
    const int phases[] = {0, 1, 2, 3, 4, 5, 6, 7, 8, 9, 10};
    for (int ph : phases) {
        a.ph_lo = ph; a.ph_hi = ph + 1;
        hipLaunchKernelGGL(mk_fwd, dim3(grid), dim3(NWAVES * 64), LDS_BYTES, stream, a);
    }
#else
    a.ph_lo = 0; a.ph_hi = 11;
    hipLaunchKernelGGL(mk_fwd, dim3(grid), dim3(NWAVES * 64), LDS_BYTES, stream, a);
#endif
    const hipError_t le = hipPeekAtLastError();
    if (le != hipSuccess) fprintf(stderr, "kernel_launch: launch failed: %s\n", hipGetErrorName(le));
}
```

```cpp
#include <hip/hip_runtime.h>
#include <cstdio>
#include <cstdint>

#ifndef MK_PER_PHASE
#define MK_PER_PHASE 0
#endif
#ifndef MK_PROBE_LO
#define MK_PROBE_LO (-1)
#define MK_PROBE_HI (-1)
#endif
#ifndef MK_PROBE_MULT
#define MK_PROBE_MULT 4
#endif

namespace pg8 {
#define PG8_LAS __attribute__((address_space(3)))
typedef unsigned short bf16_t;
typedef short bf16x8 __attribute__((ext_vector_type(8)));
typedef float f32x4 __attribute__((ext_vector_type(4)));
typedef unsigned u32x4 __attribute__((ext_vector_type(4)));
constexpr int BM = 256, BK = 64, HALF = 128, HTB = HALF * BK * 2  , STAGE_BYTES = 8 * HTB, NXCD = 8, WGM = 8;

__host__ __device__ __forceinline__ int lds_byte(int r, int c) { const int st = (r >> 4) * 2 + (c >> 5), rr = r & 15, cc = c & 31, ob = rr * 64 + cc * 2; return st * 1024 + (ob ^ (((ob >> 9) & 1) << 5)); }
__host__ __device__ __forceinline__ void stage_rc(int b, int& R, int& C) { const int st = b / 1024, sb = b % 1024, swz = sb ^ (((sb >> 9) & 1) << 5); R = (st >> 1) * 16 + swz / 64; C = (st & 1) * 32 + (swz % 64) / 2; }
__host__ __device__ __forceinline__ int perm32(int rho) { const int n = rho >> 4, i = rho & 15; return 8 * (i >> 2) + 4 * n + (i & 3); }

struct Unit { int pm, pn; };
struct Gemm { const bf16_t* A; const bf16_t* Bt; int M, N, K; int lda; int ksplit; int kjump; };

struct StaticOrder {
    int nM, nN, nwg, G, c;
    __host__ __device__ void init(int M, int N, int G_, int c_) { nM = M / BM; nN = N / BM; nwg = nM * nN; G = G_; c = c_; }
    __host__ __device__ bool next(int i, Unit& u) const {
        const long L = (long)i * G + c; if (L >= nwg) return false;
        int wgid = (int)L; { const int q = nwg / NXCD, r = nwg % NXCD, xcd = wgid % NXCD, off = wgid / NXCD; wgid = (xcd < r ? xcd * (q + 1) : r * (q + 1) + (xcd - r) * q) + off; }
        const int nig = WGM * nN, gid = wgid / nig, fm = gid * WGM, gsz = (nM - fm) < WGM ? (nM - fm) : WGM;
        u.pm = fm + ((wgid % nig) % gsz); u.pn = (wgid % nig) / gsz; return true;
    }
    __device__ __forceinline__ void a_ready(const Unit&) const {}
    __device__ __forceinline__ void done(const Unit&) const {}
};

__device__ __forceinline__ unsigned cvt_pk_bf16(float lo, float hi) { unsigned r; asm volatile("v_cvt_pk_bf16_f32 %0, %1, %2" : "=v"(r) : "v"(lo), "v"(hi)); return r; }
__device__ __forceinline__ u32x4 pack8(const f32x4 v0, const f32x4 v1) { u32x4 w; w.x = cvt_pk_bf16(v0[0], v0[1]); w.y = cvt_pk_bf16(v0[2], v0[3]); w.z = cvt_pk_bf16(v1[0], v1[1]); w.w = cvt_pk_bf16(v1[2], v1[3]); return w; }

__device__ __forceinline__ float ep_silu(float x) { return x * __builtin_amdgcn_rcpf(1.0f + __expf(-x)); }
struct EpiProj {
    static constexpr bool PERM = true, AFTER_DRAIN = false;
    bf16_t* O; int ldc; const float* lbl; const float* dtb; bf16_t* xhalo;
    __device__ __forceinline__ void operator()(const f32x4 (&acc)[2][2][4][2], const Unit& u, int wr, int wc, int fr, int fq) const {
        const int row0 = u.pm * BM + wr * 64 + fr, col0 = u.pn * BM + wc * 32 + 8 * fq;
        const int kind = (u.pn < 4) ? 1 : (u.pn < 8 ? 2 : (u.pn < 12 ? 0 : (u.pn < 20 ? 1 : (u.pn == 26 ? 3 : 0))));
        float par[2][8];
        if (kind == 2) {
#pragma unroll
            for (int bj = 0; bj < 2; ++bj)
#pragma unroll
                for (int j = 0; j < 8; ++j) { const int c = col0 + bj * HALF + j - 1024; par[bj][j] = __builtin_amdgcn_rcpf(1.0f + __expf(lbl[1024 + c] - lbl[c])); }
        } else if (kind == 3) {
#pragma unroll
            for (int bj = 0; bj < 2; ++bj)
#pragma unroll
                for (int j = 0; j < 8; ++j) { const int c = col0 + bj * HALF + j - 6656; par[bj][j] = (c >= 0 && c < 16) ? dtb[c] : 0.f; }
        }
#pragma unroll
        for (int ai = 0; ai < 2; ++ai)
#pragma unroll
            for (int m = 0; m < 4; ++m) { const int row = row0 + ai * HALF + m * 16; bf16_t* rowp = O + (size_t)row * ldc + col0;
                int hslot = -1; if (u.pn >= 20 && u.pn < 26) { if (row < 16384) { if ((row & 63) >= 61) hslot = (row >> 6) * 3 + (row & 63) - 61; } else if (row >= 16397 && row < 16400) hslot = 256 * 3 + row - 16397; }
#pragma unroll
                for (int bj = 0; bj < 2; ++bj) { f32x4 v0 = acc[ai][bj][m][0], v1 = acc[ai][bj][m][1];
                    if (hslot >= 0) *(u32x4*)(xhalo + (size_t)hslot * 1536 + (col0 + bj * HALF - 5120)) = pack8(v0, v1);
                    if (kind == 1) {
#pragma unroll
                        for (int j = 0; j < 4; ++j) { v0[j] = ep_silu(v0[j]); v1[j] = ep_silu(v1[j]); }
                    } else if (kind == 2) {
#pragma unroll
                        for (int j = 0; j < 4; ++j) { const float l0 = par[bj][j], l1 = par[bj][4 + j];
                            v0[j] = __logf(l0 + (1.0f - l0) * __builtin_amdgcn_rcpf(1.0f + __expf(-v0[j]))); v1[j] = __logf(l1 + (1.0f - l1) * __builtin_amdgcn_rcpf(1.0f + __expf(-v1[j]))); }
                    } else if (kind == 3) {
#pragma unroll
                        for (int j = 0; j < 4; ++j) { const float x0 = v0[j] + par[bj][j], x1 = v1[j] + par[bj][4 + j]; const float u0 = __expf(x0), u1 = __expf(x1);
                            const float s0 = u0 * (1.0f - u0 * (0.5f - u0 * (0.33333334f - u0 * 0.25f))), s1 = u1 * (1.0f - u1 * (0.5f - u1 * (0.33333334f - u1 * 0.25f)));
                            v0[j] = x0 > 20.f ? x0 : (u0 < 0.0625f ? s0 : __logf(1.0f + u0)); v1[j] = x1 > 20.f ? x1 : (u1 < 0.0625f ? s1 : __logf(1.0f + u1)); }
                    }
                    *(u32x4*)(rowp + bj * HALF) = pack8(v0, v1); } }
    }
};
template <bool WRITE_A2> struct EpiResid {
    static constexpr bool PERM = true, AFTER_DRAIN = false;
    const float* base; float* out; bf16_t* a2; int lda2; float* rss;
    __device__ __forceinline__ void operator()(const f32x4 (&acc)[2][2][4][2], const Unit& u, int wr, int wc, int fr, int fq) const {
        const int row0 = u.pm * BM + wr * 64 + fr, col0 = u.pn * BM + wc * 32 + 8 * fq;
#pragma unroll
        for (int ai = 0; ai < 2; ++ai)
#pragma unroll
            for (int m = 0; m < 4; ++m) { const int row = row0 + ai * HALF + m * 16; float ss = 0.f;
#pragma unroll
                for (int bj = 0; bj < 2; ++bj) { const size_t o = (size_t)row * 1024 + col0 + bj * HALF;
                    const f32x4 v0 = acc[ai][bj][m][0] + *(const f32x4*)(base + o), v1 = acc[ai][bj][m][1] + *(const f32x4*)(base + o + 4);
                    *(f32x4*)(out + o) = v0; *(f32x4*)(out + o + 4) = v1;
                    ss += (v0[0] * v0[0] + v0[1] * v0[1]) + (v0[2] * v0[2] + v0[3] * v0[3]) + (v1[0] * v1[0] + v1[1] * v1[1]) + (v1[2] * v1[2] + v1[3] * v1[3]);
                    if (WRITE_A2) *(u32x4*)(a2 + (size_t)row * lda2 + col0 + bj * HALF) = pack8(v0, v1); }
                ss += __shfl_xor(ss, 16); ss += __shfl_xor(ss, 32);
                if (fq == 0) rss[(size_t)row * 16 + u.pn * 4 + wc] = ss; }
    }
};
struct EpiUp {
    static constexpr bool PERM = true, AFTER_DRAIN = false;
    bf16_t* proj; const float* rss; bf16_t* halo;
    __device__ __forceinline__ void operator()(const f32x4 (&acc)[2][2][4][2], const Unit& u, int wr, int wc, int fr, int fq) const {
        const int row0 = u.pm * BM + wr * 64 + fr, jc = u.pn * 128 + wc * 32 + 8 * fq;
        const int dcol[2] = { 2048 + jc, (u.pn < 8) ? jc : jc + 3840 };
#pragma unroll
        for (int ai = 0; ai < 2; ++ai)
#pragma unroll
            for (int m = 0; m < 4; ++m) { const int row = row0 + ai * HALF + m * 16;
                const f32x4* rp = (const f32x4*)(rss + (size_t)row * 16); const f32x4 a = rp[0], b = rp[1], c = rp[2], d = rp[3];
                const float tot = (((a[0] + a[1]) + (a[2] + a[3])) + ((b[0] + b[1]) + (b[2] + b[3]))) + (((c[0] + c[1]) + (c[2] + c[3])) + ((d[0] + d[1]) + (d[2] + d[3])));
                const float rs = 1.0f / sqrtf(tot * (1.0f / 1024.0f) + 1e-6f);
#pragma unroll
                for (int bj = 0; bj < 2; ++bj) { const u32x4 w = pack8(acc[ai][bj][m][0] * rs, acc[ai][bj][m][1] * rs);
                    *(u32x4*)(proj + (size_t)row * 6912 + dcol[bj]) = w;
                    if ((row & 63) >= 62) *(u32x4*)(halo + (size_t)((row >> 6) * 2 + (row & 1)) * 5632 + bj * 2816 + jc) = w; } }
    }
};

template <class Epi, class Sched, bool ALIGN_EPI = false, bool SP2 = false>
__device__ __forceinline__ void gemm_phase(PG8_LAS unsigned char* lds, const Gemm g, const Sched& S, const Epi& E) {
    const int tid = threadIdx.x, wid = __builtin_amdgcn_readfirstlane(tid >> 6), lane = tid & 63, wr = wid >> 2, wc = wid & 3, fr = lane & 15, fq = lane >> 4;
    const int K = g.K, nt = K / BK, lda = g.lda;
    unsigned voffA[2], voffB[2];
#pragma unroll
    for (int i = 0; i < 2; ++i) { int R, C; stage_rc(tid * 16 + i * 8192, R, C); const int Rb = Epi::PERM ? ((R & ~31) + perm32(R & 31)) : R;
        voffA[i] = (unsigned)(R * lda + C) * 2u; voffB[i] = (unsigned)(Rb * K + C) * 2u; }
    const size_t kstep = (size_t)(BK * 2);
    const size_t hstepA = (size_t)HALF * lda * 2, tstepA = 2 * hstepA;
    const size_t hstepB = (size_t)HALF * K * 2, tstepB = 2 * hstepB;
    const int ksplit = g.ksplit; const size_t kjump = (size_t)g.kjump;
#define PG8_AK(kt) ((size_t)(kt) * kstep + (((kt) >= ksplit) ? kjump : (size_t)0))
    const unsigned ldsw = (unsigned)wid * 1024u;
    const int aoff = lds_byte(wr * 64 + fr, fq * 8), boff = lds_byte(wc * 32 + fr, fq * 8);
#define PG8_SA(b, h) (((b) * 2 + (h)) * HTB)
#define PG8_SB(b, h) ((4 + (b) * 2 + (h)) * HTB)
#define PG8_STAGE(bufoff, gbase, voff) do { _Pragma("unroll") for (int _i = 0; _i < 2; ++_i) \
        __builtin_amdgcn_global_load_lds((const unsigned*)((const char*)(gbase) + (voff)[_i]), (PG8_LAS unsigned*)(lds + (bufoff) + ldsw + _i * 8192), 16, 0, 0); } while (0)
#define PG8_LDA(dst, b, h) do { _Pragma("unroll") for (int m = 0; m < 4; ++m) _Pragma("unroll") for (int k = 0; k < 2; ++k) dst[m][k] = *(const PG8_LAS bf16x8*)(lds + PG8_SA(b, h) + aoff + m * 2048 + k * 1024); } while (0)
#define PG8_LDB(dst, b, h) do { _Pragma("unroll") for (int n = 0; n < 2; ++n) _Pragma("unroll") for (int k = 0; k < 2; ++k) dst[n][k] = *(const PG8_LAS bf16x8*)(lds + PG8_SB(b, h) + boff + n * 2048 + k * 1024); } while (0)
#define PG8_MMA(ai, bj, At, Bt) do { __builtin_amdgcn_s_setprio(1); _Pragma("unroll") for (int m = 0; m < 4; ++m) _Pragma("unroll") for (int n = 0; n < 2; ++n) _Pragma("unroll") for (int k = 0; k < 2; ++k) \
        acc[ai][bj][m][n] = __builtin_amdgcn_mfma_f32_16x16x32_bf16(Bt[n][k], At[m][k], acc[ai][bj][m][n], 0, 0, 0); __builtin_amdgcn_s_setprio(0); } while (0)
#define PG8_WAIT_V(n) asm volatile("s_waitcnt vmcnt(" #n ")" ::: "memory")
#define PG8_WAIT_L(n) asm volatile("s_waitcnt lgkmcnt(" #n ")" ::: "memory")
#define PG8_BAR __builtin_amdgcn_s_barrier()
#define PG8_SCHED __builtin_amdgcn_sched_barrier(0)
    Unit cur, nxt; int ui = 0;
    if (!S.next(0, cur)) return;
    f32x4 acc[2][2][4][2];
#pragma unroll
    for (int a = 0; a < 2; ++a)
#pragma unroll
        for (int b = 0; b < 2; ++b)
#pragma unroll
            for (int m = 0; m < 4; ++m)
#pragma unroll
                for (int n = 0; n < 2; ++n) acc[a][b][m][n] = (f32x4){0.f, 0.f, 0.f, 0.f};
    bf16x8 At[4][2], B0[2][2], B1[2][2];
    const char* cA = (const char*)g.A + (size_t)cur.pm * tstepA; const char* cB = (const char*)g.Bt + (size_t)cur.pn * tstepB;
    S.a_ready(cur);
    if constexpr (SP2) {
        PG8_STAGE(PG8_SB(0, 0), cB, voffB); PG8_STAGE(PG8_SB(0, 1), cB + hstepB, voffB); PG8_STAGE(PG8_SA(0, 0), cA, voffA); PG8_STAGE(PG8_SA(0, 1), cA + hstepA, voffA);
        if (wr == 1) PG8_BAR;
        PG8_WAIT_V(2); PG8_BAR;
        PG8_STAGE(PG8_SB(1, 0), cB + kstep, voffB); PG8_STAGE(PG8_SA(1, 0), cA + PG8_AK(1), voffA); PG8_STAGE(PG8_SB(1, 1), cB + hstepB + kstep, voffB);
        PG8_WAIT_V(6); PG8_BAR;
    } else {
        PG8_STAGE(PG8_SB(0, 0), cB, voffB); PG8_STAGE(PG8_SA(0, 0), cA, voffA); PG8_STAGE(PG8_SB(0, 1), cB + hstepB, voffB); PG8_STAGE(PG8_SA(0, 1), cA + hstepA, voffA);
        if (wr == 1) PG8_BAR;
        PG8_WAIT_V(4); PG8_BAR;
        PG8_STAGE(PG8_SB(1, 0), cB + kstep, voffB); PG8_STAGE(PG8_SA(1, 0), cA + PG8_AK(1), voffA); PG8_STAGE(PG8_SB(1, 1), cB + hstepB + kstep, voffB);
        PG8_WAIT_V(6); PG8_BAR;
    }
    for (;;) {
        const bool has_next = S.next(ui + 1, nxt);
        const char* nA = has_next ? (const char*)g.A + (size_t)nxt.pm * tstepA : cA; const char* nB = has_next ? (const char*)g.Bt + (size_t)nxt.pn * tstepB : cB;
        for (int t = 0; t < nt; t += 2) {
            const bool last = (t == nt - 2);
            const char* a1 = cA + PG8_AK(t + 1);
            const char* a2 = last ? nA : cA + PG8_AK(t + 2); const char* b2 = last ? nB : cB + (size_t)(t + 2) * kstep;
            const char* a3 = last ? nA + PG8_AK(1) : cA + PG8_AK(t + 3); const char* b3 = b2 + kstep;
            if (last && has_next) S.a_ready(nxt);
            if constexpr (SP2) {
            PG8_LDB(B0, 0, 0); PG8_LDB(B1, 0, 1); PG8_SCHED; PG8_LDA(At, 0, 0); PG8_STAGE(PG8_SA(1, 1), a1 + hstepA, voffA);
            PG8_WAIT_V(8); PG8_WAIT_L(0); PG8_BAR; PG8_MMA(0, 0, At, B0); PG8_MMA(0, 1, At, B1); PG8_BAR; PG8_SCHED;
            PG8_LDA(At, 0, 1); PG8_STAGE(PG8_SB(0, 0), b2, voffB); PG8_STAGE(PG8_SB(0, 1), b2 + hstepB, voffB); PG8_STAGE(PG8_SA(0, 0), a2, voffA);
            PG8_WAIT_V(8); PG8_WAIT_L(0); PG8_BAR; PG8_MMA(1, 0, At, B0); PG8_MMA(1, 1, At, B1); PG8_BAR; PG8_SCHED;
            PG8_LDB(B0, 1, 0); PG8_LDB(B1, 1, 1); PG8_SCHED; PG8_LDA(At, 1, 0); PG8_STAGE(PG8_SA(0, 1), a2 + hstepA, voffA);
            PG8_WAIT_V(8); PG8_WAIT_L(0); PG8_BAR; PG8_MMA(0, 0, At, B0); PG8_MMA(0, 1, At, B1); PG8_BAR; PG8_SCHED;
            PG8_LDA(At, 1, 1); PG8_STAGE(PG8_SB(1, 0), b3, voffB); PG8_STAGE(PG8_SB(1, 1), b3 + hstepB, voffB); PG8_STAGE(PG8_SA(1, 0), a3, voffA);
            PG8_WAIT_V(8); PG8_WAIT_L(0); PG8_BAR; PG8_MMA(1, 0, At, B0); PG8_MMA(1, 1, At, B1); PG8_BAR; PG8_SCHED;
            } else {
            PG8_LDB(B0, 0, 0); PG8_SCHED; PG8_LDA(At, 0, 0); PG8_STAGE(PG8_SA(1, 1), a1 + hstepA, voffA);
            PG8_WAIT_L(8); PG8_BAR; PG8_WAIT_L(0); PG8_MMA(0, 0, At, B0); PG8_BAR; PG8_SCHED;
            PG8_LDB(B1, 0, 1); PG8_STAGE(PG8_SB(0, 0), b2, voffB);
            PG8_BAR; PG8_WAIT_L(0); PG8_MMA(0, 1, At, B1); PG8_BAR;
            PG8_LDA(At, 0, 1); PG8_STAGE(PG8_SA(0, 0), a2, voffA);
            PG8_BAR; PG8_WAIT_L(0); PG8_MMA(1, 0, At, B0); PG8_BAR; PG8_SCHED;
            PG8_STAGE(PG8_SB(0, 1), b2 + hstepB, voffB);
            PG8_WAIT_V(6); PG8_BAR; PG8_MMA(1, 1, At, B1); PG8_BAR;
            PG8_LDB(B0, 1, 0); PG8_SCHED; PG8_LDA(At, 1, 0); PG8_STAGE(PG8_SA(0, 1), a2 + hstepA, voffA);
            PG8_WAIT_L(8); PG8_BAR; PG8_WAIT_L(0); PG8_MMA(0, 0, At, B0); PG8_BAR; PG8_SCHED;
            PG8_LDB(B1, 1, 1); PG8_STAGE(PG8_SB(1, 0), b3, voffB);
            PG8_BAR; PG8_WAIT_L(0); PG8_MMA(0, 1, At, B1); PG8_BAR;
            PG8_LDA(At, 1, 1); PG8_STAGE(PG8_SA(1, 0), a3, voffA);
            PG8_BAR; PG8_WAIT_L(0); PG8_MMA(1, 0, At, B0); PG8_BAR; PG8_SCHED;
            PG8_STAGE(PG8_SB(1, 1), b3 + hstepB, voffB);
            PG8_WAIT_V(6); PG8_BAR; PG8_MMA(1, 1, At, B1); PG8_BAR;
            }
        }
        if constexpr (ALIGN_EPI) { if (wr == 0) PG8_BAR; }
        if constexpr (!Epi::AFTER_DRAIN) { E(acc, cur, wr, wc, fr, fq); S.done(cur); }
        if (!has_next) break;
#pragma unroll
        for (int a = 0; a < 2; ++a)
#pragma unroll
            for (int b = 0; b < 2; ++b)
#pragma unroll
                for (int m = 0; m < 4; ++m)
#pragma unroll
                    for (int n = 0; n < 2; ++n) acc[a][b][m][n] = (f32x4){0.f, 0.f, 0.f, 0.f};
        cur = nxt; cA = nA; cB = nB; ++ui;
        if constexpr (ALIGN_EPI) { if (wr == 1) PG8_BAR; }
    }
    PG8_WAIT_V(0);
    if constexpr (!ALIGN_EPI) { if (wr == 0) PG8_BAR; }
    PG8_BAR;
#undef PG8_AK
#undef PG8_SA
#undef PG8_SB
#undef PG8_STAGE
#undef PG8_LDA
#undef PG8_LDB
#undef PG8_MMA
#undef PG8_WAIT_V
#undef PG8_WAIT_L
#undef PG8_BAR
#undef PG8_SCHED
}
}

constexpr int NWAVES = 8;
constexpr int NB = 4, SEQ = 4096, DM = 1024, NMETA = 16;
constexpr int MREAL = NB * SEQ;
constexpr int MROWS = MREAL + NMETA;
constexpr int M1 = 16640;
constexpr int NPROJ = 6672, LDP = 6912;
constexpr int Q0 = 0, F0 = 1024, I0 = 2048, G0 = 3072, Z0 = 4096, XBC0 = 5120, DT0 = 6656;
constexpr int DFF = 2816, NUP = 2 * DFF;
constexpr float EPS = 1e-6f;

constexpr size_t MiB = 1u << 20;
constexpr size_t WS_CTL = 0, CTL_ZERO_BYTES = 1 * MiB;
constexpr size_t WS_WTOUT = 1 * MiB;
constexpr size_t WS_WTUP = 5 * MiB;
constexpr size_t WS_WTDN = 16 * MiB;
constexpr size_t WS_SSQ = 22 * MiB;
constexpr size_t WS_RSS = 23 * MiB + 512 * 1024;
constexpr size_t WS_MIXMETA = 24 * MiB + 512 * 1024;
constexpr size_t WS_H2M = WS_MIXMETA + 64 * 1024;
constexpr size_t WS_PMETA = WS_H2M + 16 * 1024;
constexpr size_t WS_HALO = 25 * MiB;
constexpr size_t WS_PROJ = 31 * MiB;
constexpr size_t WS_END = WS_PROJ + (size_t)M1 * LDP * 2;
static_assert(WS_END <= 256 * MiB, "d_ws map");
constexpr size_t DO_U = 0, DO_WTIN = 34 * MiB;
static_assert(DO_WTIN + (size_t)LDP * DM * 2 <= 64 * MiB && (size_t)M1 * DM * 2 <= DO_WTIN, "d_out scratch map");
constexpr int CW_BAR = 4096;

constexpr int RING_OFF = 0, RING_BYTES = 131072;
constexpr int LDSCTL_OFF = RING_BYTES, MISC_OFF = LDSCTL_OFF + 320;
constexpr int LDS_BYTES = 147456;

#define GAS __attribute__((address_space(1)))
#define LAS __attribute__((address_space(3)))
typedef unsigned short bf16;
typedef unsigned v4u __attribute__((ext_vector_type(4)));
typedef float f32x4 __attribute__((ext_vector_type(4)));
typedef short bf16x8 __attribute__((ext_vector_type(8)));
typedef GAS unsigned gu32;
#define RLX_AGENT __ATOMIC_RELAXED, __HIP_MEMORY_SCOPE_AGENT
#define LDS_WAIT() asm volatile("s_waitcnt lgkmcnt(0)" ::: "memory")
#define VM_WAIT() asm volatile("s_waitcnt vmcnt(0)" ::: "memory")
__device__ __forceinline__ unsigned f2bf(float f) { unsigned u = __builtin_bit_cast(unsigned, f); return (u + 0x7fffu + ((u >> 16) & 1u)) >> 16; }
typedef float f32x2_t_ __attribute__((ext_vector_type(2)));
typedef __bf16 bf16x2_t_ __attribute__((ext_vector_type(2)));
__device__ __forceinline__ unsigned pk2(float lo, float hi) { const f32x2_t_ v = {lo, hi}; const bf16x2_t_ b = __builtin_convertvector(v, bf16x2_t_); return __builtin_bit_cast(unsigned, b); }
__device__ __forceinline__ float bf2f(unsigned short b) { return __builtin_bit_cast(float, ((unsigned)b) << 16); }
__device__ __forceinline__ float bflo(unsigned w) { return __builtin_bit_cast(float, w << 16); }
__device__ __forceinline__ float bfhi(unsigned w) { return __builtin_bit_cast(float, w & 0xffff0000u); }
__device__ __forceinline__ float sigmoidf_(float x) { return __builtin_amdgcn_rcpf(1.0f + __expf(-x)); }
__device__ __forceinline__ float siluf_(float x) { return x * __builtin_amdgcn_rcpf(1.0f + __expf(-x)); }
__device__ __forceinline__ float softplusf_(float x) { const float u = __expf(x); const float ser = u * (1.0f - u * (0.5f - u * (0.33333334f - u * 0.25f))); return x > 20.f ? x : (u < 0.0625f ? ser : __logf(1.0f + u)); }

#define XB_TMO      128
#define XB_XCNT(j)  (256  + 64 * (j))
#define XB_XSUB(j)  (1280 + 64 * (j))
#define XB_XGEN(j)  (2304 + 64 * (j))
#define XB_TOP      3328
#define XB_TOPGEN   3392
#define XCD_BAR_WORDS 3456
#define XB_SPIN_CAP (1u << 18)
__device__ __forceinline__ unsigned xb_ld(unsigned* p)              { return __hip_atomic_load(p, __ATOMIC_RELAXED, __HIP_MEMORY_SCOPE_AGENT); }
__device__ __forceinline__ unsigned xb_add(unsigned* p, unsigned v) { return __hip_atomic_fetch_add(p, v, __ATOMIC_RELAXED, __HIP_MEMORY_SCOPE_AGENT); }
__device__ __forceinline__ unsigned xb_xcc_id() { return (unsigned)__builtin_amdgcn_s_getreg((3 << 11) | 20) & 0xFu; }
#define XB_SPIN(cond, bar) do { unsigned _sp = 0; while (cond) { __builtin_amdgcn_s_sleep(1); \
    if ((++_sp & 255u) == 0u) { if (xb_ld(&(bar)[XB_TMO])) break; if (_sp > XB_SPIN_CAP) { atomicAdd(&(bar)[XB_TMO], 1u); break; } } } } while (0)
struct XcdBarrier { unsigned* bar; unsigned x; volatile LAS unsigned* st; };
__device__ __forceinline__ XcdBarrier xcd_barrier_post(unsigned* bar, volatile LAS unsigned* st) {
    XcdBarrier b; b.bar = bar; b.x = xb_xcc_id(); b.st = st;
    if (threadIdx.x == 0) (void)xb_add(&bar[XB_XCNT(b.x)], 1u);
    return b;
}
__device__ __forceinline__ void xcd_barrier_complete(unsigned* bar, unsigned x, unsigned& nloc, unsigned& nx) {
    const unsigned G = gridDim.x * gridDim.y * gridDim.z;
    unsigned sum, cnt, mine, sp = 0u;
    for (;;) {
        sum = 0u; cnt = 0u; mine = 0u;
#pragma unroll
        for (unsigned j = 0; j < 16; ++j) { const unsigned c = xb_ld(&bar[XB_XCNT(j)]); sum += c; cnt += (c > 0u) ? 1u : 0u; mine = (j == x) ? c : mine; }
        if (sum == G) break;
        __builtin_amdgcn_s_sleep(1);
        if ((++sp & 255u) == 0u) { if (xb_ld(&bar[XB_TMO])) break; if (sp > XB_SPIN_CAP) { atomicAdd(&bar[XB_TMO], 1u); break; } }
    }
    nloc = mine > 0u ? mine : 1u; nx = cnt > 0u ? cnt : 1u;
}
__device__ __forceinline__ void xcd_barrier(const XcdBarrier& b) {
    asm volatile("s_waitcnt vmcnt(0)" ::: "memory");
    __syncthreads();
    if (threadIdx.x == 0) {
        unsigned* bar = b.bar;
        __builtin_amdgcn_s_waitcnt(0);
        unsigned nloc = b.st[0], nx = b.st[1];
        if (nloc == 0u) { xcd_barrier_complete(bar, b.x, nloc, nx); b.st[0] = nloc; b.st[1] = nx; }
        const unsigned old = xb_add(&bar[XB_XSUB(b.x)], 1u);
        const unsigned gen = old / nloc;
        if (old + 1u == (gen + 1u) * nloc) {
            __builtin_amdgcn_fence(__ATOMIC_RELEASE, "agent");
            asm volatile("s_waitcnt vmcnt(0)" ::: "memory");
            const unsigned og = xb_add(&bar[XB_TOP], 1u);
            const unsigned tg = og / nx;
            if (og + 1u == (tg + 1u) * nx) xb_add(&bar[XB_TOPGEN], 1u);
            else XB_SPIN(xb_ld(&bar[XB_TOPGEN]) == tg, bar);
            __builtin_amdgcn_fence(__ATOMIC_ACQUIRE, "agent");
            xb_add(&bar[XB_XGEN(b.x)], 1u);
            asm volatile("s_waitcnt vmcnt(0)" ::: "memory");
        } else {
            XB_SPIN(xb_ld(&bar[XB_XGEN(b.x)]) == gen, bar);
            __builtin_amdgcn_fence(__ATOMIC_ACQUIRE, "agent");
            asm volatile("s_waitcnt vmcnt(0)" ::: "memory");
        }
    }
    __syncthreads();
}

struct Args { const float* in[19]; float* out; unsigned char* ws; int ph_lo, ph_hi; };
enum { IN_X = 0, IN_META, IN_N1W, IN_WIN, IN_LBL, IN_HGNW, IN_CW, IN_CB, IN_DTB, IN_ALOG, IN_D, IN_M2NW, IN_WOUT, IN_N2W, IN_WUP, IN_FCW, IN_FCB, IN_WDN, IN_FNW };

struct Frame {
    LAS unsigned char* lds;
    int tid, lane, wave, vcu, G;
};

__device__ __forceinline__ float wave_sum(float v) {
#pragma unroll
    for (int o = 1; o < 64; o <<= 1) v += __shfl_xor(v, o);
    return v;
}

typedef short p0_s4 __attribute__((ext_vector_type(4)));
typedef short p0_s8 __attribute__((ext_vector_type(8)));
__device__ __forceinline__ p0_s4 p0_tr4(const LAS unsigned char* p) { return __builtin_bit_cast(p0_s4, __builtin_amdgcn_ds_read_tr16_b64_v4i16((LAS p0_s4*)p)); }
__device__ __forceinline__ void p0_transpose_item(const float* W, int K, int N, int nvalid, bf16* WT, int drow0, int scol0, int k0, const float* kscale, LAS unsigned char* tile, int lane) {
    const int c4 = (lane & 15) * 4, r4 = lane >> 4, c = scol0 + c4; const bool okc = c < nvalid; const int cc = okc ? c : 0;
    f32x4 v[16];
#pragma unroll
    for (int i = 0; i < 16; ++i) v[i] = *(const f32x4*)(W + (size_t)(k0 + 4 * i + r4) * N + cc);
#pragma unroll
    for (int i = 0; i < 16; ++i) { const int row = 4 * i + r4; f32x4 x = okc ? v[i] : (f32x4){0.f, 0.f, 0.f, 0.f}; if (kscale) x = x * kscale[k0 + row];
        *(LAS unsigned long long*)(tile + row * 144 + c4 * 2) = (unsigned long long)pk2(x[0], x[1]) | ((unsigned long long)pk2(x[2], x[3]) << 32); }
    LDS_WAIT(); asm volatile("" ::: "memory");
    const int gq = lane >> 4, q = (lane & 15) >> 2, p = lane & 3, n = 16 * gq + (lane & 15);
#pragma unroll
    for (int it = 0; it < 8; ++it) { const p0_s4 lo = p0_tr4(tile + (8 * it + q) * 144 + (16 * gq + 4 * p) * 2), hi = p0_tr4(tile + (8 * it + 4 + q) * 144 + (16 * gq + 4 * p) * 2);
        *(GAS v4u*)(WT + (size_t)(drow0 + n) * K + k0 + 8 * it) = __builtin_bit_cast(v4u, __builtin_shufflevector(lo, hi, 0, 1, 2, 3, 4, 5, 6, 7)); }
    LDS_WAIT(); asm volatile("" ::: "memory");
}
__device__ __forceinline__ void rms_rows2_to_bf16(int lane, const float* x0, const float* x1, const float* w, bf16* o0, bf16* o1) {
    const float* xs[2] = {x0, x1}; bf16* os[2] = {o0, o1};
    f32x4 v[2][4];
#pragma unroll
    for (int r = 0; r < 2; ++r)
#pragma unroll
        for (int j = 0; j < 4; ++j) v[r][j] = ((const GAS f32x4*)(xs[r] ? xs[r] : w))[lane + 64 * j];
    const GAS f32x4* wr = (const GAS f32x4*)w + lane;
#pragma unroll
    for (int r = 0; r < 2; ++r) { if (os[r] == nullptr) continue; float s = 0.f;
#pragma unroll
        for (int j = 0; j < 4; ++j) s += (v[r][j].x * v[r][j].x + v[r][j].y * v[r][j].y) + (v[r][j].z * v[r][j].z + v[r][j].w * v[r][j].w);
        const float rs = xs[r] ? 1.f / sqrtf(wave_sum(s) * (1.f / DM) + EPS) : 0.f;
        GAS unsigned long long* o8 = (GAS unsigned long long*)os[r] + lane;
#pragma unroll
        for (int j = 0; j < 4; ++j) { const f32x4 ww = wr[64 * j]; o8[64 * j] = (unsigned long long)pk2(v[r][j].x * rs * ww.x, v[r][j].y * rs * ww.y) | ((unsigned long long)pk2(v[r][j].z * rs * ww.z, v[r][j].w * rs * ww.w) << 32); } }
}

__device__ __forceinline__ void p0_prologue(const Frame& F, const Args& a) {
    LAS unsigned char* scr = F.lds + RING_OFF + F.wave * 16384;
    const int gw = F.vcu * NWAVES + F.wave, NGW = F.G * NWAVES;
    bf16* WTin = (bf16*)((unsigned char*)a.out + DO_WTIN); bf16* WTout = (bf16*)(a.ws + WS_WTOUT); bf16* WTup = (bf16*)(a.ws + WS_WTUP); bf16* WTdn = (bf16*)(a.ws + WS_WTDN);
    constexpr int I_IN = (LDP / 64) * (DM / 64), I_OUT = (DM / 64) * (2048 / 64), I_UP = (NUP / 64) * (DM / 64), I_DN = (DM / 64) * (DFF / 64);
    constexpr int NITEMS = I_IN + I_OUT + I_UP + I_DN;
    for (int it = gw; it < NITEMS; it += NGW) {
        int r = it;
        if (r < I_IN) { const int nb = r % (LDP / 64), kb = r / (LDP / 64); p0_transpose_item(a.in[IN_WIN], DM, NPROJ, NPROJ, WTin, nb * 64, nb * 64, kb * 64, nullptr, scr, F.lane); continue; } r -= I_IN;
        if (r < I_OUT) { const int nb = r % (DM / 64), kb = r / (DM / 64); p0_transpose_item(a.in[IN_WOUT], 2048, DM, DM, WTout, nb * 64, nb * 64, kb * 64, nullptr, scr, F.lane); continue; } r -= I_OUT;
        if (r < I_UP) { const int nb = r % (NUP / 64), kb = r / (NUP / 64); const int d0 = nb * 64, pn = d0 >> 8, rem = d0 & 255, bj = rem >> 7, j = rem & 127;
            p0_transpose_item(a.in[IN_WUP], DM, NUP, NUP, WTup, d0, bj * DFF + pn * 128 + j, kb * 64, a.in[IN_N2W], scr, F.lane); continue; } r -= I_UP;
        { const int nb = r % (DM / 64), kb = r / (DM / 64); p0_transpose_item(a.in[IN_WDN], DFF, DM, DM, WTdn, nb * 64, nb * 64, kb * 64, nullptr, scr, F.lane); }
    }
    bf16* U = (bf16*)((unsigned char*)a.out + DO_U);
    for (int m = gw; m < M1; m += 2 * NGW) { const int m1 = m + NGW;
        const float* s0 = (m < MREAL) ? a.in[IN_X] + (size_t)m * DM : (m < MROWS ? a.in[IN_META] + (size_t)(m - MREAL) * DM : nullptr);
        const float* s1 = (m1 < MREAL) ? a.in[IN_X] + (size_t)m1 * DM : (m1 < MROWS ? a.in[IN_META] + (size_t)(m1 - MREAL) * DM : nullptr);
        rms_rows2_to_bf16(F.lane, s0, s1, a.in[IN_N1W], U + (size_t)m * DM, m1 < M1 ? U + (size_t)m1 * DM : nullptr);
    }
}

__device__ __forceinline__ void p4_groupnorm(const Frame& F, const Args& a) {
    const int gw = F.vcu * NWAVES + F.wave, NGW = F.G * NWAVES;
    bf16* proj = (bf16*)(a.ws + WS_PROJ); bf16* mixmeta = (bf16*)(a.ws + WS_MIXMETA); const float* ssq = (const float*)(a.ws + WS_SSQ);
    for (int m = gw; m < MROWS; m += NGW) {
        bf16* p = (m < MREAL) ? proj + (size_t)m * LDP + Z0 : mixmeta + (size_t)(m - MREAL) * 2048 + 1024;
        const int g = F.lane >> 5; const f32x4* sp = (const f32x4*)(ssq + (size_t)m * 16 + g * 8); const f32x4 s0 = sp[0], s1 = sp[1];
        const float tot = ((s0[0] + s0[1]) + (s0[2] + s0[3])) + ((s1[0] + s1[1]) + (s1[2] + s1[3]));
        const float sc = 1.f / sqrtf(tot * (1.f / 512.f) + EPS);
        v4u* q = (v4u*)(p + F.lane * 16);
#pragma unroll
        for (int j = 0; j < 2; ++j) { v4u w = q[j]; v4u o;
            o.x = pk2(bflo(w.x) * sc, bfhi(w.x) * sc); o.y = pk2(bflo(w.y) * sc, bfhi(w.y) * sc); o.z = pk2(bflo(w.z) * sc, bfhi(w.z) * sc); o.w = pk2(bflo(w.w) * sc, bfhi(w.w) * sc); q[j] = o; }
    }
}
__device__ __forceinline__ float wave_dot_bf16(const bf16* x, const bf16* w, int n, int lane) {
    float s = 0.f;
    for (int i = lane * 8; i < n; i += 512) { const v4u a = *(const v4u*)(x + i), b = *(const v4u*)(w + i);
        s += bflo(a.x) * bflo(b.x) + bfhi(a.x) * bfhi(b.x) + bflo(a.y) * bflo(b.y) + bfhi(a.y) * bfhi(b.y) + bflo(a.z) * bflo(b.z) + bfhi(a.z) * bfhi(b.z) + bflo(a.w) * bflo(b.w) + bfhi(a.w) * bfhi(b.w); }
    return wave_sum(s);
}
__device__ __forceinline__ void p5_meta_tail(const Frame& F, const Args& a) {
    const int gw = F.vcu * NWAVES + F.wave, NGW = F.G * NWAVES;
    const bf16* mixmeta = (const bf16*)(a.ws + WS_MIXMETA); const bf16* WTout = (const bf16*)(a.ws + WS_WTOUT); float* h2m = (float*)(a.ws + WS_H2M);
    for (int o = gw; o < 2 * DM; o += NGW) { const int i = o / DM, n = o % DM;
        const float d = wave_dot_bf16(mixmeta + (size_t)(14 + i) * 2048, WTout + (size_t)n * 2048, 2048, F.lane);
        if (F.lane == 0) h2m[o] = a.in[IN_META][(size_t)(14 + i) * DM + n] + d; }
}
__device__ __forceinline__ void p6_meta_tail(const Frame& F, const Args& a) {
    const int gw = F.vcu * NWAVES + F.wave, NGW = F.G * NWAVES;
    const bf16* WTup = (const bf16*)(a.ws + WS_WTUP); const float* h2m = (const float*)(a.ws + WS_H2M); float* pmeta = (float*)(a.ws + WS_PMETA);
    for (int o = gw; o < 2 * NUP; o += NGW) { const int i = o / NUP, c = o % NUP; const int isv = c >= DFF, cc = isv ? c - DFF : c, n = (cc >> 7) * 256 + isv * 128 + (cc & 127);
        const float* h = h2m + (size_t)i * DM; const bf16* w = WTup + (size_t)n * DM; float s = 0.f, ss = 0.f;
        for (int k = F.lane * 8; k < DM; k += 512) { const f32x4 h0 = *(const f32x4*)(h + k), h1 = *(const f32x4*)(h + k + 4); const v4u b = *(const v4u*)(w + k);
            ss += (h0[0] * h0[0] + h0[1] * h0[1]) + (h0[2] * h0[2] + h0[3] * h0[3]) + (h1[0] * h1[0] + h1[1] * h1[1]) + (h1[2] * h1[2] + h1[3] * h1[3]);
            s += bf2f(f2bf(h0[0])) * bflo(b.x) + bf2f(f2bf(h0[1])) * bfhi(b.x) + bf2f(f2bf(h0[2])) * bflo(b.y) + bf2f(f2bf(h0[3])) * bfhi(b.y)
               + bf2f(f2bf(h1[0])) * bflo(b.z) + bf2f(f2bf(h1[1])) * bfhi(b.z) + bf2f(f2bf(h1[2])) * bflo(b.w) + bf2f(f2bf(h1[3])) * bfhi(b.w); }
        s = wave_sum(s); ss = wave_sum(ss);
        if (F.lane == 0) pmeta[o] = s / sqrtf(ss * (1.f / DM) + EPS); }
}
__device__ __forceinline__ void p7_conv_glu(const Frame& F, const Args& a) {
    bf16* proj = (bf16*)(a.ws + WS_PROJ); const bf16* halo = (const bf16*)(a.ws + WS_HALO); const float* pmeta = (const float*)(a.ws + WS_PMETA);
    const float* cw = a.in[IN_FCW]; const float* cb = a.in[IN_FCB];
    constexpr int CG = DFF / 8;
    const int NT = F.G * NWAVES * 64;
    for (int it = (F.vcu * NWAVES + F.wave) * 64 + F.lane; it < 256 * CG; it += NT) {
        const int rb = it / CG, c0 = (it % CG) * 8;
        const int vcol = (c0 < 1024) ? c0 : c0 + 3840;
        float wg[3][8], wv[3][8], bg[8], bv[8], g2[8], g1[8], v2[8], v1[8];
#pragma unroll
        for (int k = 0; k < 3; ++k)
#pragma unroll
            for (int j = 0; j < 8; ++j) { wg[k][j] = cw[k * NUP + c0 + j]; wv[k][j] = cw[k * NUP + DFF + c0 + j]; }
#pragma unroll
        for (int j = 0; j < 8; ++j) { bg[j] = cb[c0 + j]; bv[j] = cb[DFF + c0 + j]; }
        if ((rb & 63) == 0) {
#pragma unroll
            for (int j = 0; j < 8; ++j) { g2[j] = pmeta[c0 + j]; v2[j] = pmeta[DFF + c0 + j]; g1[j] = pmeta[NUP + c0 + j]; v1[j] = pmeta[NUP + DFF + c0 + j]; }
        } else {
            const bf16* h = halo + (size_t)((rb - 1) * 2) * NUP;
            const v4u a0 = *(const v4u*)(h + c0), a1 = *(const v4u*)(h + DFF + c0), b0 = *(const v4u*)(h + NUP + c0), b1 = *(const v4u*)(h + NUP + DFF + c0);
            g2[0] = bflo(a0.x); g2[1] = bfhi(a0.x); g2[2] = bflo(a0.y); g2[3] = bfhi(a0.y); g2[4] = bflo(a0.z); g2[5] = bfhi(a0.z); g2[6] = bflo(a0.w); g2[7] = bfhi(a0.w);
            v2[0] = bflo(a1.x); v2[1] = bfhi(a1.x); v2[2] = bflo(a1.y); v2[3] = bfhi(a1.y); v2[4] = bflo(a1.z); v2[5] = bfhi(a1.z); v2[6] = bflo(a1.w); v2[7] = bfhi(a1.w);
            g1[0] = bflo(b0.x); g1[1] = bfhi(b0.x); g1[2] = bflo(b0.y); g1[3] = bfhi(b0.y); g1[4] = bflo(b0.z); g1[5] = bfhi(b0.z); g1[6] = bflo(b0.w); g1[7] = bfhi(b0.w);
            v1[0] = bflo(b1.x); v1[1] = bfhi(b1.x); v1[2] = bflo(b1.y); v1[3] = bfhi(b1.y); v1[4] = bflo(b1.z); v1[5] = bfhi(b1.z); v1[6] = bflo(b1.w); v1[7] = bfhi(b1.w);
        }
        bf16* rowp = proj + (size_t)(rb * 64) * LDP;
#pragma unroll 2
        for (int r = 0; r < 64; ++r, rowp += LDP) {
            const v4u pg = *(const v4u*)(rowp + 2048 + c0), pv = *(const v4u*)(rowp + vcol);
            float g0[8], v0[8], o[8];
            g0[0] = bflo(pg.x); g0[1] = bfhi(pg.x); g0[2] = bflo(pg.y); g0[3] = bfhi(pg.y); g0[4] = bflo(pg.z); g0[5] = bfhi(pg.z); g0[6] = bflo(pg.w); g0[7] = bfhi(pg.w);
            v0[0] = bflo(pv.x); v0[1] = bfhi(pv.x); v0[2] = bflo(pv.y); v0[3] = bfhi(pv.y); v0[4] = bflo(pv.z); v0[5] = bfhi(pv.z); v0[6] = bflo(pv.w); v0[7] = bfhi(pv.w);
#pragma unroll
            for (int j = 0; j < 8; ++j) { const float ug = bg[j] + wg[0][j] * g2[j] + wg[1][j] * g1[j] + wg[2][j] * g0[j]; const float uv = bv[j] + wv[0][j] * v2[j] + wv[1][j] * v1[j] + wv[2][j] * v0[j];
                o[j] = siluf_(ug) * uv; g2[j] = g1[j]; g1[j] = g0[j]; v2[j] = v1[j]; v1[j] = v0[j]; }
            v4u w; w.x = pk2(o[0], o[1]); w.y = pk2(o[2], o[3]); w.z = pk2(o[4], o[5]); w.w = pk2(o[6], o[7]);
            *(v4u*)(rowp + 2048 + c0) = w;
        }
    }
}
__device__ __forceinline__ void p9_final_norm(const Frame& F, const Args& a) {
    const int gw = F.vcu * NWAVES + F.wave, NGW = F.G * NWAVES;
    const float* rss = (const float*)(a.ws + WS_SSQ); const f32x4* wv = (const f32x4*)a.in[IN_FNW] + F.lane;
    for (int m = gw; m < MREAL; m += NGW) {
        const f32x4* rp = (const f32x4*)(rss + (size_t)m * 16); const f32x4 sa = rp[0], sb = rp[1], sc_ = rp[2], sd = rp[3];
        const float tot = (((sa[0] + sa[1]) + (sa[2] + sa[3])) + ((sb[0] + sb[1]) + (sb[2] + sb[3]))) + (((sc_[0] + sc_[1]) + (sc_[2] + sc_[3])) + ((sd[0] + sd[1]) + (sd[2] + sd[3])));
        const float rs = 1.f / sqrtf(tot * (1.f / DM) + EPS);
        f32x4* o = (f32x4*)(a.out + (size_t)m * DM) + F.lane;
#pragma unroll
        for (int j = 0; j < 4; ++j) { const f32x4 v = o[64 * j], w = wv[64 * j]; o[64 * j] = v * rs * w; }
    }
}

namespace mix {
constexpr size_t DO_HGU = 0, DO_MBU = 16 * MiB, DO_HGD = 32 * MiB, DO_MBD = 33 * MiB, DO_SV = 40 * MiB, DO_XHALO = 48 * MiB;
typedef unsigned long long u64;
typedef short bf16x4 __attribute__((ext_vector_type(4)));
typedef short v4i16_t __attribute__((ext_vector_type(4)));
#define MFMA16(a, b, c) __builtin_amdgcn_mfma_f32_16x16x32_bf16((a), (b), (c), 0, 0, 0)

__device__ __forceinline__ unsigned row_off(int b, int p) { return (unsigned)(p < NMETA ? (MREAL + p) : b * SEQ + (p - NMETA)) * (unsigned)(LDP * 2); }
__device__ __forceinline__ float ldbf(const unsigned char* base, unsigned off) { return bf2f(*(const bf16*)(base + off)); }
__device__ __forceinline__ unsigned off256(unsigned row, unsigned ch) { return 272u * row + 16u * ch; }
__device__ __forceinline__ unsigned off128(unsigned row, unsigned ch) { return 144u * row + 16u * ch; }
__device__ __forceinline__ bf16x4 tr4(const LAS unsigned char* p) { return __builtin_bit_cast(bf16x4, __builtin_amdgcn_ds_read_tr16_b64_v4i16((LAS v4i16_t*)p)); }
__device__ __forceinline__ bf16x8 cat8(bf16x4 a, bf16x4 b) { return __builtin_shufflevector(a, b, 0, 1, 2, 3, 4, 5, 6, 7); }
__device__ __forceinline__ bf16x8 frag_nat(const LAS unsigned char* T, int rb, int s, int lane) { return *(const LAS bf16x8*)(T + off256((unsigned)((lane & 15) + 16 * rb), (unsigned)(4 * s + (lane >> 4)))); }
__device__ __forceinline__ bf16x8 frag_tr(const LAS unsigned char* T, int c, int ks, int lane) { const unsigned g = lane >> 4, q = (lane & 15) >> 2, p = lane & 3;
    return cat8(tr4(T + off256(32u * ks + 8u * g + q, 2u * c + (p >> 1)) + 8u * (p & 1)), tr4(T + off256(32u * ks + 8u * g + 4u + q, 2u * c + (p >> 1)) + 8u * (p & 1))); }
__device__ __forceinline__ bf16x8 frag_tr128(const LAS unsigned char* T, int c, int ks, int lane) { const unsigned g = lane >> 4, q = (lane & 15) >> 2, p = lane & 3;
    return cat8(tr4(T + off128(32u * ks + 8u * g + q, 2u * c + (p >> 1)) + 8u * (p & 1)), tr4(T + off128(32u * ks + 8u * g + 4u + q, 2u * c + (p >> 1)) + 8u * (p & 1))); }
__device__ __forceinline__ bf16x4 cl4(const LAS unsigned char* T, int R0, int c, int lane) { const unsigned g = lane >> 4, q = (lane & 15) >> 2, p = lane & 3; return tr4(T + off256((unsigned)R0 + 4u * g + q, 2u * c + (p >> 1)) + 8u * (p & 1)); }
__device__ __forceinline__ bf16x8 frag_perm(const LAS unsigned char* T, int rb, int ks, int lane) { const unsigned row = (lane & 15) + 16 * rb, g = lane >> 4;
    return cat8(*(const LAS bf16x4*)(T + off256(row, 4u * ks + (g >> 1)) + 8u * (g & 1)), *(const LAS bf16x4*)(T + off256(row, 4u * ks + 2u + (g >> 1)) + 8u * (g & 1))); }
__device__ __forceinline__ bf16x8 pack_state(const f32x4 a, const f32x4 b) { v4u w; w.x = pk2(a[0], a[1]); w.y = pk2(a[2], a[3]); w.z = pk2(b[0], b[1]); w.w = pk2(b[2], b[3]); return __builtin_bit_cast(bf16x8, w); }
__device__ __forceinline__ void unpack8(const v4u w, float* x) { x[0] = bflo(w.x); x[1] = bfhi(w.x); x[2] = bflo(w.y); x[3] = bfhi(w.y); x[4] = bflo(w.z); x[5] = bfhi(w.z); x[6] = bflo(w.w); x[7] = bfhi(w.w); }
__device__ __forceinline__ v4u pack8f(const float* x) { v4u w; w.x = pk2(x[0], x[1]); w.y = pk2(x[2], x[3]); w.z = pk2(x[4], x[5]); w.w = pk2(x[6], x[7]); return w; }
__device__ __forceinline__ float bf4(const bf16x4 v, int e) { return bf2f((unsigned short)v[e]); }

struct TileRegs { v4u r[2]; };
__device__ __forceinline__ void tile_issue(TileRegs& R, const unsigned char* pb, int b, int c, int colbytes, int tid) {
#pragma unroll
    for (int i = 0; i < 2; ++i) { const int q = tid + 512 * i, row = q >> 4, ch = q & 15, p = c * 64 + row - 48; R.r[i] = *(const v4u*)(pb + row_off(b, p >= 0 ? p : 0) + (unsigned)(colbytes + ch * 16)); }
}
__device__ __forceinline__ void tile_commit(const TileRegs& R, LAS unsigned char* T, int c, int tid) {
#pragma unroll
    for (int i = 0; i < 2; ++i) { const int q = tid + 512 * i, row = q >> 4, ch = q & 15, p = c * 64 + row - 48; *(LAS v4u*)(T + off256((unsigned)row, (unsigned)ch)) = p >= 0 ? R.r[i] : (v4u){0u, 0u, 0u, 0u}; }
}
__device__ __forceinline__ v4u ot_read(const LAS unsigned char* OT, int v0, int lane) { const unsigned g = lane >> 4, q = (lane & 15) >> 2, p = lane & 3;
    const bf16x4 lo = tr4(OT + off128((unsigned)v0 + q, 2u * g + (p >> 1)) + 8u * (p & 1)), hi = tr4(OT + off128((unsigned)v0 + 4u + q, 2u * g + (p >> 1)) + 8u * (p & 1)); return __builtin_bit_cast(v4u, cat8(lo, hi)); }

__device__ __forceinline__ int hg_sv_slot(int b, int h, int c) { return c == 0 ? 2048 + h : ((b * 8 + h) * 64 + c - 1); }
__device__ __forceinline__ void prep_hgrn2(LAS unsigned char* L, const Args& a, int item, int tid) {
    int b, h, c; if (item < 2048) { c = 1 + (item & 63); h = (item >> 6) & 7; b = item >> 9; } else { c = 0; b = 0; h = item - 2048; }
    unsigned char* pb = a.ws + WS_PROJ; float* SV = (float*)((unsigned char*)a.out + DO_SV) + (size_t)hg_sv_slot(b, h, c) * 384;
    LAS float* segtot = (LAS float*)L; LAS float* bmv = (LAS float*)(L + 16384);
    const int cg = tid & 15, rs = tid >> 4;
    const int p0 = c * 64 + 2 * rs - 48, p1 = p0 + 1; const bool ok0 = p0 >= 0, ok1 = p1 >= 0;
    const unsigned ro0 = row_off(b, ok0 ? p0 : 0) + (unsigned)(h * 128 + cg * 8) * 2u, ro1 = row_off(b, ok1 ? p1 : 0) + (unsigned)(h * 128 + cg * 8) * 2u;
    float lf0[8], lf1[8], q0[8], q1[8];
    { const v4u a0 = *(const v4u*)(pb + ro0 + F0 * 2), a1 = *(const v4u*)(pb + ro1 + F0 * 2), b0 = *(const v4u*)(pb + ro0 + Q0 * 2), b1 = *(const v4u*)(pb + ro1 + Q0 * 2);
      unpack8(a0, lf0); unpack8(a1, lf1); unpack8(b0, q0); unpack8(b1, q1); }
#pragma unroll
    for (int j = 0; j < 8; ++j) { if (!ok0) { lf0[j] = 0.f; q0[j] = 0.f; } if (!ok1) { lf1[j] = 0.f; q1[j] = 0.f; } }
    { f32x4 s0, s1;
#pragma unroll
      for (int j = 0; j < 4; ++j) { s0[j] = lf0[j] + lf1[j]; s1[j] = lf0[4 + j] + lf1[4 + j]; }
      *(LAS f32x4*)(segtot + rs * 128 + cg * 8) = s0; *(LAS f32x4*)(segtot + rs * 128 + cg * 8 + 4) = s1; }
    __syncthreads();
    if (tid < 128) { float run = 0.f, bmid = 0.f;
#pragma unroll 8
        for (int s_ = 0; s_ < 32; ++s_) { const float v = segtot[s_ * 128 + tid]; segtot[s_ * 128 + tid] = run; if (s_ == 16) bmid = run; run += v; }
        bmv[tid] = bmid; SV[tid] = __expf(run); SV[128 + tid] = __expf(run - bmid); SV[256 + tid] = __expf(bmid); }
    __syncthreads();
    { const f32x4 o0 = *(const LAS f32x4*)(segtot + rs * 128 + cg * 8), o1 = *(const LAS f32x4*)(segtot + rs * 128 + cg * 8 + 4), m0 = *(const LAS f32x4*)(bmv + cg * 8), m1 = *(const LAS f32x4*)(bmv + cg * 8 + 4);
      float qd0[8], qd1[8], ki0[8], ki1[8];
#pragma unroll
      for (int j = 0; j < 8; ++j) { const float off = j < 4 ? o0[j] : o1[j - 4], bm = j < 4 ? m0[j] : m1[j - 4]; const float bc0 = off + lf0[j], bc1 = bc0 + lf1[j];
          qd0[j] = q0[j] * __expf(bc0 - bm); qd1[j] = q1[j] * __expf(bc1 - bm); ki0[j] = (1.f - __expf(lf0[j])) * __expf(bm - bc0); ki1[j] = (1.f - __expf(lf1[j])) * __expf(bm - bc1); }
      if (ok0) { *(v4u*)(pb + ro0 + Q0 * 2) = pack8f(qd0); *(v4u*)(pb + ro0 + F0 * 2) = pack8f(ki0); }
      if (ok1) { *(v4u*)(pb + ro1 + Q0 * 2) = pack8f(qd1); *(v4u*)(pb + ro1 + F0 * 2) = pack8f(ki1); } }
    __syncthreads();
}
__device__ __forceinline__ void prep_mamba(const Args& a, int item, int tid) {
    int b, grp, c; if (item < 512) { c = 1 + (item & 63); grp = (item >> 6) & 1; b = item >> 7; } else { c = 0; b = 0; grp = item - 512; }
    unsigned char* pb = a.ws + WS_PROJ; const unsigned char* xh = (const unsigned char*)a.out + DO_XHALO;
    const int cc = tid % 96, rsg = tid / 96; const bool act = tid < 480;
    const int col = cc < 64 ? grp * 512 + cc * 8 : (cc < 80 ? 1024 + grp * 128 + (cc - 64) * 8 : 1280 + grp * 128 + (cc - 80) * 8);
    const int rlo = rsg * 13;
    v4u raw[16];
#pragma unroll
    for (int i = 0; i < 16; ++i) { const int r = rlo - 3 + i, p = c * 64 + r - 48; v4u v = (v4u){0u, 0u, 0u, 0u};
        if (act && p >= 0 && r < 64) { if (r >= 0) v = *(const v4u*)(pb + row_off(b, p) + (unsigned)(XBC0 + col) * 2u);
            else { const int slot = (c == 1) ? 256 : b * 64 + (c - 2); v = *(const v4u*)(xh + ((size_t)(slot * 3 + r + 3) * 1536 + col) * 2); } }
        raw[i] = v; }
    float w[4][8], bia[8];
    { const float* cw = a.in[IN_CW]; const float* cb = a.in[IN_CB];
#pragma unroll
      for (int k = 0; k < 4; ++k) { const f32x4 w0 = *(const f32x4*)(cw + k * 1536 + col), w1 = *(const f32x4*)(cw + k * 1536 + col + 4);
#pragma unroll
          for (int j = 0; j < 4; ++j) { w[k][j] = w0[j]; w[k][4 + j] = w1[j]; } }
      const f32x4 b0 = *(const f32x4*)(cb + col), b1 = *(const f32x4*)(cb + col + 4);
#pragma unroll
      for (int j = 0; j < 4; ++j) { bia[j] = b0[j]; bia[4 + j] = b1[j]; } }
    __syncthreads();
    float x0[8], x1[8], x2[8], x3[8];
    unpack8(raw[0], x0); unpack8(raw[1], x1); unpack8(raw[2], x2);
#pragma unroll
    for (int i = 0; i < 13; ++i) { unpack8(raw[i + 3], x3); const int r = rlo + i, p = c * 64 + r - 48; float o[8];
#pragma unroll
        for (int j = 0; j < 8; ++j) { o[j] = siluf_(bia[j] + w[0][j] * x0[j] + w[1][j] * x1[j] + w[2][j] * x2[j] + w[3][j] * x3[j]); x0[j] = x1[j]; x1[j] = x2[j]; x2[j] = x3[j]; }
        if (act && p >= 0 && r < 64) *(v4u*)(pb + row_off(b, p) + (unsigned)(XBC0 + col) * 2u) = pack8f(o); }
}

template <bool OUT>
__device__ __forceinline__ void hgrn2_item(LAS unsigned char* L, const Args& a, int bh, int j, int tid, int wave, int lane) {
    const int b = bh >> 3, h = bh & 7, n = lane & 15, g = lane >> 4;
    unsigned char* pb = a.ws + WS_PROJ; bf16* mixmeta = (bf16*)(a.ws + WS_MIXMETA);
    float* HGU = (float*)((unsigned char*)a.out + DO_HGU); float* HGD = (float*)((unsigned char*)a.out + DO_HGD); const float* SVg = (const float*)((const unsigned char*)a.out + DO_SV);
    LAS unsigned char* T_QD = L; LAS unsigned char* T_KI = L + 17408; LAS unsigned char* T_V = L + 34816; LAS unsigned char* T_G = L + 52224; LAS unsigned char* T_SC = L + 69632; LAS unsigned char* T_OT = L + 78848;
    LAS float* sv = (LAS float*)(L + 97280); LAS float* red = (LAS float*)(L + 97280 + 2048); LAS float* rinv = (LAS float*)(L + 97280 + 4096);
    f32x4 S[8];
#pragma unroll
    for (int kt = 0; kt < 8; ++kt) S[kt] = (f32x4){0.f, 0.f, 0.f, 0.f};
    f32x4 Dp[8];
    if (OUT) {
        for (int i = 0; i < j; ++i) { const float* U = HGU + ((size_t)(bh * 7 + i)) * 16384 + (size_t)(wave * 8 * 64 + lane) * 4; const float* D = HGD + (size_t)(bh * 7 + i) * 128 + 4 * g;
#pragma unroll
            for (int kt = 0; kt < 8; ++kt) { const f32x4 d4 = *(const f32x4*)(D + kt * 16), u4 = *(const f32x4*)(U + kt * 256); S[kt] = S[kt] * d4 + u4; } }
    } else {
#pragma unroll
        for (int kt = 0; kt < 8; ++kt) Dp[kt] = (f32x4){1.f, 1.f, 1.f, 1.f};
    }
    const int c0 = j == 0 ? 0 : 8 * j + 1, c1 = 8 * j + 8;
    TileRegs RQ, RK, RV, RG; f32x4 Rsv = (f32x4){0.f, 0.f, 0.f, 0.f};
#define HG_ISSUE(cn) do { const int cb_ = (h * 128) * 2; if (OUT) { tile_issue(RQ, pb, b, (cn), Q0 * 2 + cb_, tid); tile_issue(RG, pb, b, (cn), G0 * 2 + cb_, tid); } \
        tile_issue(RK, pb, b, (cn), F0 * 2 + cb_, tid); tile_issue(RV, pb, b, (cn), I0 * 2 + cb_, tid); \
        if (tid < 96) Rsv = *(const f32x4*)(SVg + (size_t)hg_sv_slot(b, h, (cn)) * 384 + tid * 4); } while (0)
    HG_ISSUE(c0);
    const int tid_in = tid, lane_in = lane;
    for (int c = c0; c <= c1; ++c) {
        int tid = tid_in, lane = lane_in; asm volatile("" : "+v"(tid), "+v"(lane));
        const int n = lane & 15, g = lane >> 4;
        if (OUT) { tile_commit(RQ, T_QD, c, tid); tile_commit(RG, T_G, c, tid); }
        tile_commit(RK, T_KI, c, tid); tile_commit(RV, T_V, c, tid);
        if (tid < 96) *(LAS f32x4*)(sv + tid * 4) = Rsv;
        if (c < c1) HG_ISSUE(c + 1);
        __syncthreads();
        bf16x8 vf[2];
#pragma unroll
        for (int ts = 0; ts < 2; ++ts) vf[ts] = frag_tr(T_V, wave, ts, lane);
        f32x4 O[4]; bf16x4 gq[4];
        if (OUT) {
            const int ti = wave >> 1;
#pragma unroll
            for (int q = 0; q < 2; ++q) { const int si = 2 * (wave & 1) + q; f32x4 acc = (f32x4){0.f, 0.f, 0.f, 0.f};
                if (si <= ti) { bf16x8 fa[4], fb[4];
#pragma unroll
                    for (int ks = 0; ks < 4; ++ks) { fa[ks] = frag_nat(T_QD, ti, ks, lane); fb[ks] = frag_nat(T_KI, si, ks, lane); }
                    __builtin_amdgcn_sched_barrier(0);
#pragma unroll
                    for (int ks = 0; ks < 4; ++ks) acc = MFMA16(fa[ks], fb[ks], acc); }
                float m[4];
#pragma unroll
                for (int r = 0; r < 4; ++r) m[r] = (ti * 16 + 4 * g + r >= si * 16 + n) ? acc[r] : 0.f;
                u64 w = (u64)pk2(m[0], m[1]) | ((u64)pk2(m[2], m[3]) << 32);
                *(LAS u64*)(T_SC + off128((unsigned)(si * 16 + n), (unsigned)(2 * ti + (g >> 1))) + 8u * (g & 1)) = w; }
#pragma unroll
            for (int tt = 0; tt < 4; ++tt) gq[tt] = cl4(T_G, tt * 16, wave, lane);
            __syncthreads();
            { bf16x8 fs[4][2];
#pragma unroll
              for (int tt = 0; tt < 4; ++tt)
#pragma unroll
                for (int ss = 0; ss < 2; ++ss) if (ss * 32 <= tt * 16 + 15) fs[tt][ss] = frag_tr128(T_SC, tt, ss, lane);
              __builtin_amdgcn_sched_barrier(0);
#pragma unroll
              for (int tt = 0; tt < 4; ++tt) { O[tt] = (f32x4){0.f, 0.f, 0.f, 0.f};
#pragma unroll
                for (int ss = 0; ss < 2; ++ss) if (ss * 32 <= tt * 16 + 15) O[tt] = MFMA16(fs[tt][ss], vf[ss], O[tt]); } }
            bf16x8 sb[4];
#pragma unroll
            for (int ks = 0; ks < 4; ++ks) { const f32x4 e0 = *(const LAS f32x4*)(sv + 256 + (2 * ks) * 16 + 4 * g), e1 = *(const LAS f32x4*)(sv + 256 + (2 * ks + 1) * 16 + 4 * g); sb[ks] = pack_state(S[2 * ks] * e0, S[2 * ks + 1] * e1); }
            { bf16x8 fq[4][4];
#pragma unroll
              for (int tt = 0; tt < 4; ++tt)
#pragma unroll
                for (int ks = 0; ks < 4; ++ks) fq[tt][ks] = frag_perm(T_QD, tt, ks, lane);
              __builtin_amdgcn_sched_barrier(0);
#pragma unroll
              for (int ks = 0; ks < 4; ++ks)
#pragma unroll
                for (int tt = 0; tt < 4; ++tt) O[tt] = MFMA16(fq[tt][ks], sb[ks], O[tt]); }
        }
        { bf16x8 fk[8][2]; f32x4 T[8];
#pragma unroll
          for (int kt = 0; kt < 8; ++kt)
#pragma unroll
            for (int ts = 0; ts < 2; ++ts) fk[kt][ts] = frag_tr(T_KI, kt, ts, lane);
          __builtin_amdgcn_sched_barrier(0);
#pragma unroll
          for (int kt = 0; kt < 8; ++kt) T[kt] = MFMA16(fk[kt][0], vf[0], ((f32x4){0.f, 0.f, 0.f, 0.f}));
#pragma unroll
          for (int kt = 0; kt < 8; ++kt) T[kt] = MFMA16(fk[kt][1], vf[1], T[kt]);
#pragma unroll
          for (int kt = 0; kt < 8; ++kt) { const f32x4 d4 = *(const LAS f32x4*)(sv + kt * 16 + 4 * g), e4 = *(const LAS f32x4*)(sv + 128 + kt * 16 + 4 * g); S[kt] = S[kt] * d4 + e4 * T[kt];
            if (!OUT) Dp[kt] = Dp[kt] * d4; } }
        if (OUT) {
#pragma unroll
            for (int tt = 0; tt < 4; ++tt)
#pragma unroll
                for (int r = 0; r < 4; ++r) { float ss = O[tt][r] * O[tt][r]; ss += __shfl_xor(ss, 1); ss += __shfl_xor(ss, 2); ss += __shfl_xor(ss, 4); ss += __shfl_xor(ss, 8); if (n == 0) red[wave * 64 + tt * 16 + 4 * g + r] = ss; }
            __syncthreads();
            if (tid < 64) { float tot = 0.f;
#pragma unroll
                for (int w = 0; w < 8; ++w) tot += red[w * 64 + tid];
                rinv[tid] = 1.f / sqrtf(tot * (1.f / 128.f) + EPS); }
            __syncthreads();
            const float nw = a.in[IN_HGNW][h * 128 + wave * 16 + n];
#pragma unroll
            for (int tt = 0; tt < 4; ++tt) { const f32x4 ri = *(const LAS f32x4*)(rinv + tt * 16 + 4 * g); float o[4];
#pragma unroll
                for (int r = 0; r < 4; ++r) o[r] = O[tt][r] * ri[r] * nw * bf4(gq[tt], r);
                *(LAS u64*)(T_OT + off128((unsigned)(wave * 16 + n), (unsigned)(2 * tt + (g >> 1))) + 8u * (g & 1)) = (u64)pk2(o[0], o[1]) | ((u64)pk2(o[2], o[3]) << 32); }
            LDS_WAIT();
#pragma unroll
            for (int hf = 0; hf < 2; ++hf) { const v4u w = ot_read(T_OT, wave * 16 + 8 * hf, lane); const int p = c * 64 + 16 * g + n - 48, vc = h * 128 + wave * 16 + 8 * hf;
                if (p >= NMETA) *(v4u*)(pb + row_off(b, p) + (unsigned)(Q0 + vc) * 2u) = w;
                else if (p >= 0 && b == 0) *(v4u*)(mixmeta + (size_t)p * 2048 + vc) = w; }
        } else {
            __syncthreads();
        }
    }
#undef HG_ISSUE
    if (!OUT) {
        float* U = HGU + ((size_t)(bh * 7 + j)) * 16384 + (size_t)(wave * 8 * 64 + lane) * 4;
#pragma unroll
        for (int kt = 0; kt < 8; ++kt) *(f32x4*)(U + kt * 256) = S[kt];
        if (wave == 0 && n == 0) {
#pragma unroll
            for (int kt = 0; kt < 8; ++kt) *(f32x4*)(HGD + (size_t)(bh * 7 + j) * 128 + kt * 16 + 4 * g) = Dp[kt]; }
    }
}

template <bool OUT>
__device__ __forceinline__ void mamba_item(LAS unsigned char* L, const Args& a, int bp, int j, int tid, int wave, int lane) {
    const int b = bp >> 3, pair = bp & 7, grp = pair >> 2, hm0 = 2 * pair, n = lane & 15, g = lane >> 4, whd = wave >> 2;
    unsigned char* pb = a.ws + WS_PROJ; bf16* mixmeta = (bf16*)(a.ws + WS_MIXMETA); float* ssq = (float*)(a.ws + WS_SSQ);
    float* MBU = (float*)((unsigned char*)a.out + DO_MBU); float* MBD = (float*)((unsigned char*)a.out + DO_MBD);
    LAS unsigned char* T_X = L; LAS unsigned char* T_B = L + 17408; LAS unsigned char* T_C = L + 34816; LAS unsigned char* T_Z = L + 52224; LAS unsigned char* T_VE = L + 69632; LAS unsigned char* T_SC = L + 87040; LAS unsigned char* T_OT = L + 105472;
    LAS float* acum = (LAS float*)(L + 123904); LAS float* eac = acum + 128; LAS float* wv = acum + 256; LAS float* dtv = acum + 384; LAS float* eal = acum + 512; LAS float* red = acum + 576;
    f32x4 S[8];
#pragma unroll
    for (int kt = 0; kt < 8; ++kt) S[kt] = (f32x4){0.f, 0.f, 0.f, 0.f};
    if (OUT) {
        for (int i = 0; i < j; ++i) { const float* U = MBU + ((size_t)(bp * 7 + i)) * 16384 + (size_t)(wave * 8 * 64 + lane) * 4; const float d = MBD[(size_t)(bp * 7 + i) * 2 + whd];
#pragma unroll
            for (int kt = 0; kt < 8; ++kt) { const f32x4 u4 = *(const f32x4*)(U + kt * 256); S[kt] = S[kt] * d + u4; } }
    }
    float dprod = 1.f;
    const float Ah = -__expf(a.in[IN_ALOG][hm0 + (wave & 1)]);
    const int c0 = j == 0 ? 0 : 8 * j + 1, c1 = 8 * j + 8;
    TileRegs RX, RB, RC, RZ; float Rdt = 0.f;
#define MB_ISSUE(cn) do { tile_issue(RX, pb, b, (cn), (XBC0 + hm0 * 64) * 2, tid); tile_issue(RB, pb, b, (cn), (XBC0 + 1024 + grp * 128) * 2, tid); \
        if (OUT) { tile_issue(RC, pb, b, (cn), (XBC0 + 1280 + grp * 128) * 2, tid); tile_issue(RZ, pb, b, (cn), (Z0 + hm0 * 64) * 2, tid); } \
        if (wave < 2) { const int p_ = (cn) * 64 + lane - 48; const float d_ = ldbf(pb, row_off(b, p_ >= 0 ? p_ : 0) + (unsigned)(DT0 + hm0 + wave) * 2u); Rdt = p_ >= 0 ? d_ : 0.f; } } while (0)
    MB_ISSUE(c0);
    const int tid_in = tid, lane_in = lane;
    for (int c = c0; c <= c1; ++c) {
        int tid = tid_in, lane = lane_in; asm volatile("" : "+v"(tid), "+v"(lane));
        const int n = lane & 15, g = lane >> 4;
        tile_commit(RX, T_X, c, tid); tile_commit(RB, T_B, c, tid);
        if (OUT) { tile_commit(RC, T_C, c, tid); tile_commit(RZ, T_Z, c, tid); }
        if (wave < 2) {
            float ac = Rdt * Ah;
#pragma unroll
            for (int o = 1; o < 64; o <<= 1) { const float t_ = __shfl_up(ac, o); if (lane >= o) ac += t_; }
            const float alast = __shfl(ac, 63);
            acum[wave * 64 + lane] = ac; eac[wave * 64 + lane] = __expf(ac); wv[wave * 64 + lane] = Rdt * __expf(alast - ac); dtv[wave * 64 + lane] = Rdt;
            if (lane == 0) eal[wave] = __expf(alast);
        }
        __syncthreads();
#pragma unroll
        for (int i = 0; i < 2; ++i) { const int q = tid + 512 * i, row = q >> 4, ch = q & 15, p = c * 64 + row - 48; float x[8]; unpack8(RX.r[i], x); const float w_ = p >= 0 ? wv[(ch >> 3) * 64 + row] : 0.f;
#pragma unroll
            for (int e = 0; e < 8; ++e) x[e] *= w_;
            *(LAS v4u*)(T_VE + off256((unsigned)row, (unsigned)ch)) = pack8f(x); }
        if (c < c1) MB_ISSUE(c + 1);
        f32x4 O[4]; bf16x4 xq[4], zq[4];
        if (OUT) {
            const int ti = wave >> 1;
#pragma unroll
            for (int q = 0; q < 2; ++q) { const int si = 2 * (wave & 1) + q; f32x4 acc = (f32x4){0.f, 0.f, 0.f, 0.f};
                if (si <= ti) { bf16x8 fa[4], fb[4];
#pragma unroll
                    for (int ks = 0; ks < 4; ++ks) { fa[ks] = frag_nat(T_C, ti, ks, lane); fb[ks] = frag_nat(T_B, si, ks, lane); }
                    __builtin_amdgcn_sched_barrier(0);
#pragma unroll
                    for (int ks = 0; ks < 4; ++ks) acc = MFMA16(fa[ks], fb[ks], acc); }
#pragma unroll
                for (int h2 = 0; h2 < 2; ++h2) { const f32x4 at = *(const LAS f32x4*)(acum + h2 * 64 + ti * 16 + 4 * g); const float as = acum[h2 * 64 + si * 16 + n], ds = dtv[h2 * 64 + si * 16 + n]; float m[4];
#pragma unroll
                    for (int r = 0; r < 4; ++r) m[r] = (ti * 16 + 4 * g + r >= si * 16 + n) ? acc[r] * __expf(at[r] - as) * ds : 0.f;
                    *(LAS u64*)(T_SC + h2 * 9216 + off128((unsigned)(si * 16 + n), (unsigned)(2 * ti + (g >> 1))) + 8u * (g & 1)) = (u64)pk2(m[0], m[1]) | ((u64)pk2(m[2], m[3]) << 32); } }
#pragma unroll
            for (int tt = 0; tt < 4; ++tt) { xq[tt] = cl4(T_X, tt * 16, wave, lane); zq[tt] = cl4(T_Z, tt * 16, wave, lane); }
        }
        __syncthreads();
        if (OUT) {
            bf16x8 xf[2];
#pragma unroll
            for (int ss = 0; ss < 2; ++ss) xf[ss] = frag_tr(T_X, wave, ss, lane);
            f32x4 O2[4];
            { bf16x8 fs[4][2];
#pragma unroll
              for (int tt = 0; tt < 4; ++tt)
#pragma unroll
                for (int ss = 0; ss < 2; ++ss) if (ss * 32 <= tt * 16 + 15) fs[tt][ss] = frag_tr128(T_SC + whd * 9216, tt, ss, lane);
              __builtin_amdgcn_sched_barrier(0);
#pragma unroll
              for (int tt = 0; tt < 4; ++tt) { O[tt] = (f32x4){0.f, 0.f, 0.f, 0.f}; O2[tt] = (f32x4){0.f, 0.f, 0.f, 0.f};
#pragma unroll
                for (int ss = 0; ss < 2; ++ss) if (ss * 32 <= tt * 16 + 15) O[tt] = MFMA16(fs[tt][ss], xf[ss], O[tt]); } }
            bf16x8 sb[4];
#pragma unroll
            for (int ks = 0; ks < 4; ++ks) sb[ks] = pack_state(S[2 * ks], S[2 * ks + 1]);
            { bf16x8 fq[4][4];
#pragma unroll
              for (int tt = 0; tt < 4; ++tt)
#pragma unroll
                for (int ks = 0; ks < 4; ++ks) fq[tt][ks] = frag_perm(T_C, tt, ks, lane);
              __builtin_amdgcn_sched_barrier(0);
#pragma unroll
              for (int ks = 0; ks < 4; ++ks)
#pragma unroll
                for (int tt = 0; tt < 4; ++tt) O2[tt] = MFMA16(fq[tt][ks], sb[ks], O2[tt]); }
#pragma unroll
            for (int tt = 0; tt < 4; ++tt) { const f32x4 ea = *(const LAS f32x4*)(eac + whd * 64 + tt * 16 + 4 * g); O[tt] = O[tt] + ea * O2[tt]; }
        }
        { const float el = eal[whd]; bf16x8 vef[2];
#pragma unroll
          for (int ts = 0; ts < 2; ++ts) vef[ts] = frag_tr(T_VE, wave, ts, lane);
          bf16x8 fk[8][2];
#pragma unroll
          for (int kt = 0; kt < 8; ++kt)
#pragma unroll
            for (int ts = 0; ts < 2; ++ts) fk[kt][ts] = frag_tr(T_B, kt, ts, lane);
          __builtin_amdgcn_sched_barrier(0);
#pragma unroll
          for (int kt = 0; kt < 8; ++kt) S[kt] = MFMA16(fk[kt][0], vef[0], S[kt] * el);
#pragma unroll
          for (int kt = 0; kt < 8; ++kt) S[kt] = MFMA16(fk[kt][1], vef[1], S[kt]);
          if (!OUT) dprod *= el; }
        if (OUT) {
            float y[4][4];
            const float Dw = a.in[IN_D][hm0 + whd], nw = a.in[IN_M2NW][hm0 * 64 + wave * 16 + n];
#pragma unroll
            for (int tt = 0; tt < 4; ++tt)
#pragma unroll
                for (int r = 0; r < 4; ++r) { y[tt][r] = (O[tt][r] + Dw * bf4(xq[tt], r)) * bf4(zq[tt], r);
                    float ss = y[tt][r] * y[tt][r]; ss += __shfl_xor(ss, 1); ss += __shfl_xor(ss, 2); ss += __shfl_xor(ss, 4); ss += __shfl_xor(ss, 8); if (n == 0) red[wave * 64 + tt * 16 + 4 * g + r] = ss; }
#pragma unroll
            for (int tt = 0; tt < 4; ++tt)
                *(LAS u64*)(T_OT + off128((unsigned)(wave * 16 + n), (unsigned)(2 * tt + (g >> 1))) + 8u * (g & 1)) = (u64)pk2(y[tt][0] * nw, y[tt][1] * nw) | ((u64)pk2(y[tt][2] * nw, y[tt][3] * nw) << 32);
            __syncthreads();
            if (tid < 128) { const int h2 = tid >> 6, t = tid & 63; const float tot = (red[(4 * h2) * 64 + t] + red[(4 * h2 + 1) * 64 + t]) + (red[(4 * h2 + 2) * 64 + t] + red[(4 * h2 + 3) * 64 + t]);
                const int p = c * 64 + t - 48; if (p >= NMETA || (p >= 0 && b == 0)) ssq[(size_t)(p < NMETA ? MREAL + p : b * SEQ + p - NMETA) * 16 + hm0 + h2] = tot; }
#pragma unroll
            for (int hf = 0; hf < 2; ++hf) { const v4u w = ot_read(T_OT, wave * 16 + 8 * hf, lane); const int p = c * 64 + 16 * g + n - 48, vc = hm0 * 64 + wave * 16 + 8 * hf;
                if (p >= NMETA) *(v4u*)(pb + row_off(b, p) + (unsigned)(Z0 + vc) * 2u) = w;
                else if (p >= 0 && b == 0) *(v4u*)(mixmeta + (size_t)p * 2048 + 1024 + vc) = w; }
        } else {
            __syncthreads();
        }
    }
#undef MB_ISSUE
    if (!OUT) {
        float* U = MBU + ((size_t)(bp * 7 + j)) * 16384 + (size_t)(wave * 8 * 64 + lane) * 4;
#pragma unroll
        for (int kt = 0; kt < 8; ++kt) *(f32x4*)(U + kt * 256) = S[kt];
        if ((wave & 3) == 0 && lane == 0) MBD[(size_t)(bp * 7 + j) * 2 + whd] = dprod;
    }
}
#undef MFMA16
}

__global__ void __launch_bounds__(NWAVES * 64, 2) mk_fwd(Args args) {
    extern __shared__ __attribute__((aligned(16))) unsigned char lds[];
    Frame F;
    F.lds = (LAS unsigned char*)lds;
    F.tid = threadIdx.x; F.lane = F.tid & 63; F.wave = __builtin_amdgcn_readfirstlane(F.tid >> 6);
    F.G = gridDim.x; { const int bx = blockIdx.x; F.vcu = (F.G % 8 == 0) ? (bx % 8) * (F.G / 8) + bx / 8 : bx; }
    volatile LAS unsigned* MISC = (volatile LAS unsigned*)(F.lds + MISC_OFF);
    unsigned char* ws = args.ws;
    for (int u = F.tid; u < (LDS_BYTES - LDSCTL_OFF) / 4; u += NWAVES * 64) ((LAS unsigned*)(F.lds + LDSCTL_OFF))[u] = 0u;
    __syncthreads();
    const int lo = args.ph_lo, hi = args.ph_hi;
    const bool use_bar = (hi - lo) > 1;
    XcdBarrier bar; bar.bar = (unsigned*)(ws + WS_CTL) + CW_BAR; bar.x = 0; bar.st = nullptr;
    if (use_bar) bar = xcd_barrier_post((unsigned*)(ws + WS_CTL) + CW_BAR, MISC + 8);
#define IN(k) (lo <= (k) && (k) < hi)
#define SEAM(k) do { if (IN(k) && IN((k) + 1)) xcd_barrier(bar); } while (0)
    bf16* proj = (bf16*)(ws + WS_PROJ);

#define PRB_BEGIN(k) do { if (MK_PROBE_LO == (k) && blockIdx.x == 0 && F.tid == 0) *(volatile LAS unsigned long long*)(MISC + 16) = __builtin_amdgcn_s_memrealtime(); } while (0)
#define PRB_END(k) do { if (MK_PROBE_HI == (k) && blockIdx.x == 0 && F.tid == 0) *(volatile LAS unsigned long long*)(MISC + 18) = __builtin_amdgcn_s_memrealtime(); } while (0)
    PRB_BEGIN(0);
    if (IN(0)) { p0_prologue(F, args); SEAM(0); }
    PRB_END(0); PRB_BEGIN(1);
    if (IN(1)) {
        pg8::Gemm g{(const bf16*)((unsigned char*)args.out + DO_U), (const bf16*)((unsigned char*)args.out + DO_WTIN), M1, LDP, DM, DM, 1 << 30, 0};
        pg8::StaticOrder S; S.init(M1, LDP, F.G, (int)blockIdx.x);
        pg8::EpiProj E{proj, LDP, args.in[IN_LBL], args.in[IN_DTB], (bf16*)((unsigned char*)args.out + mix::DO_XHALO)};
        pg8::gemm_phase<pg8::EpiProj, pg8::StaticOrder, true, true>(F.lds + RING_OFF, g, S, E);
        SEAM(1);
    }
    PRB_END(1); PRB_BEGIN(2);
    if (IN(2)) {
        for (int it = F.vcu; it < 514 + 2056; it += F.G) {
            if (it < 514) mix::prep_mamba(args, it, F.tid); else mix::prep_hgrn2(F.lds + RING_OFF, args, it - 514, F.tid);
        }
        SEAM(2);
    }
    PRB_END(2); PRB_BEGIN(3);
    if (IN(3)) {
        for (int it = F.vcu; it < 448; it += F.G) {
            if (it < 224) mix::hgrn2_item<false>(F.lds + RING_OFF, args, it / 7, it % 7, F.tid, F.wave, F.lane);
            else mix::mamba_item<false>(F.lds + RING_OFF, args, (it - 224) / 7, (it - 224) % 7, F.tid, F.wave, F.lane);
        }
        SEAM(3);
    }
    PRB_END(3); PRB_BEGIN(4);
    if (IN(4)) {
        for (int it = F.vcu; it < 256; it += F.G) { mix::hgrn2_item<true>(F.lds + RING_OFF, args, it >> 3, it & 7, F.tid, F.wave, F.lane); __syncthreads(); }
        { int tid2 = F.tid; asm volatile("" : "+v"(tid2));
          const int lane2 = tid2 & 63, wave2 = __builtin_amdgcn_readfirstlane(tid2 >> 6);
          for (int it = F.vcu; it < 256; it += F.G) { mix::mamba_item<true>(F.lds + RING_OFF, args, it >> 3, 7 - (it & 7), tid2, wave2, lane2); __syncthreads(); } }
        SEAM(4);
    }
    PRB_END(4); PRB_BEGIN(5);
    if (IN(5)) { p4_groupnorm(F, args); SEAM(5); }
    PRB_END(5); PRB_BEGIN(6);
    if (IN(6)) {
        p5_meta_tail(F, args); VM_WAIT(); __syncthreads();
        pg8::Gemm g{proj, (const bf16*)(ws + WS_WTOUT), MREAL, DM, 2048, LDP, 16, (Z0 - 1024) * 2};
        pg8::StaticOrder S; S.init(MREAL, DM, F.G, (int)blockIdx.x);
        pg8::EpiResid<true> E{args.in[IN_X], args.out, proj + F0, LDP, (float*)(ws + WS_RSS)};
        pg8::gemm_phase<pg8::EpiResid<true>, pg8::StaticOrder, false, true>(F.lds + RING_OFF, g, S, E);
        SEAM(6);
    }
    PRB_END(6); PRB_BEGIN(7);
    if (IN(7)) {
        p6_meta_tail(F, args); VM_WAIT(); __syncthreads();
        pg8::Gemm g{proj + F0, (const bf16*)(ws + WS_WTUP), MREAL, NUP, DM, LDP, 1 << 30, 0};
        pg8::StaticOrder S; S.init(MREAL, NUP, F.G, (int)blockIdx.x);
        pg8::EpiUp E{proj, (const float*)(ws + WS_RSS), (bf16*)(ws + WS_HALO)};
        pg8::gemm_phase<pg8::EpiUp, pg8::StaticOrder, true, true>(F.lds + RING_OFF, g, S, E);
        SEAM(7);
    }
    PRB_END(7); PRB_BEGIN(8);
    if (IN(8)) { p7_conv_glu(F, args); SEAM(8); }
    PRB_END(8); PRB_BEGIN(9);
    if (IN(9)) {
        pg8::Gemm g{proj + 2048, (const bf16*)(ws + WS_WTDN), MREAL, DM, DFF, LDP, 1 << 30, 0};
        pg8::StaticOrder S; S.init(MREAL, DM, F.G, (int)blockIdx.x);
        pg8::EpiResid<false> E{args.out, args.out, nullptr, 0, (float*)(ws + WS_SSQ)};
        pg8::gemm_phase<pg8::EpiResid<false>, pg8::StaticOrder, false, true>(F.lds + RING_OFF, g, S, E);
        SEAM(9);
    }
    PRB_END(9); PRB_BEGIN(10);
    if (IN(10)) { p9_final_norm(F, args); }
    PRB_END(10);
    if (MK_PROBE_LO >= 0 && blockIdx.x == 0 && F.tid == 0) { const unsigned long long want = (unsigned long long)MK_PROBE_MULT * (*(volatile LAS unsigned long long*)(MISC + 18) - *(volatile LAS unsigned long long*)(MISC + 16)), t0 = __builtin_amdgcn_s_memrealtime();
        while (__builtin_amdgcn_s_memrealtime() - t0 < want) __builtin_amdgcn_s_sleep(8); }
#undef PRB_BEGIN
#undef PRB_END
#undef IN
#undef SEAM
}

extern "C" void kernel_launch(void* const* d_in, const int* in_sizes, int n_in, void* d_out, int out_size, void* d_ws, size_t ws_size, hipStream_t stream) {
    static int grid = 0;
    if (grid == 0) {
        if (n_in != 19 || in_sizes[0] != MREAL * DM || out_size != MREAL * DM || ws_size < WS_END) { fprintf(stderr, "kernel_launch: unexpected shapes (n_in %d, in0 %d, out %d, ws %zu); nothing launched\n", n_in, n_in > 0 ? in_sizes[0] : -1, out_size, ws_size); grid = -1; return; }
        int dev = 0, cus = 0;
        if (hipGetDevice(&dev) != hipSuccess || hipDeviceGetAttribute(&cus, hipDeviceAttributeMultiprocessorCount, dev) != hipSuccess) { grid = -1; return; }
        if (hipFuncSetAttribute((const void*)mk_fwd, hipFuncAttributeMaxDynamicSharedMemorySize, LDS_BYTES) != hipSuccess) { fprintf(stderr, "kernel_launch: hipFuncSetAttribute failed\n"); grid = -1; return; }
        (void)hipGetLastError();
        grid = cus;
    }
    if (grid < 0) return;
    if (hipMemsetAsync((char*)d_ws + WS_CTL, 0, CTL_ZERO_BYTES, stream) != hipSuccess) { fprintf(stderr, "kernel_launch: memset failed\n"); return; }
    Args a{};
    for (int i = 0; i < 19; ++i) a.in[i] = (const float*)d_in[i];
    a.out = (float*)d_out; a.ws = (unsigned char*)d_ws;
#if MK_PER_PHASE
    const int phases[] = {0, 1, 2, 3, 4, 5, 6, 7, 8, 9, 10};
    for (int ph : phases) {
        a.ph_lo = ph; a.ph_hi = ph + 1;
        hipLaunchKernelGGL(mk_fwd, dim3(grid), dim3(NWAVES * 64), LDS_BYTES, stream, a);
    }
#else
    a.ph_lo = 0; a.ph_hi = 11;
    hipLaunchKernelGGL(mk_fwd, dim3(grid), dim3(NWAVES * 64), LDS_BYTES, stream, a);
#endif
    const hipError_t le = hipPeekAtLastError();
    if (le != hipSuccess) fprintf(stderr, "kernel_launch: launch failed: %s\n", hipGetErrorName(le));
}
```
